# Optimizing an MI355X kernel written in HIP

```python
import math
import jax, jax.numpy as jnp
from jax import lax
import numpy as np

D_MODEL = 2048
BATCH = 16
SEQ = 256
DEPTH = 4
DEC_BATCH = 2
DEC_SEQ = 1024
PAST_LEN = 256

GRID_W = 64
N_EVEN = (DEPTH + 1) // 2
N_ODD = DEPTH // 2
N_MOD = 9
FFN_HIDDEN = 5632
EPS = 1e-6
NEG = -1e30

S5_WIDTH = D_MODEL // 2
S5_GROUP = 16
S5_GROUPS = S5_WIDTH // S5_GROUP
S5_P = 64
RET_HEADS = 8
RET_DK = (D_MODEL // 2) // RET_HEADS
RET_DV = RET_DK
RET_WIDTH = RET_HEADS * RET_DV
RET_CHUNK = 128
EVEN_IN = S5_WIDTH + 4 * RET_WIDTH

POOL_WIDTH = D_MODEL // 2
POOL_WINDOWS = (2, 4, 8, 16)
POOL_GROUPS = 4
POOL_GC = POOL_WIDTH // POOL_GROUPS
ATT_HEADS = 8
ATT_KV = 2
ATT_HD = (D_MODEL // 2) // ATT_HEADS
ATT_GROUP = ATT_HEADS // ATT_KV
ATT_WIN = 128
ATT_BLOCK = 128
ODD_IN = POOL_WIDTH + (ATT_HEADS + 2 * ATT_KV) * ATT_HD
ROPE_BASE = 10000.0

kernel_name = 'hybrid_diffusion_prefix_trunk_step'

F32 = jnp.float32


def rmsnorm(x, g):
    x32 = x.astype(F32)
    y = x32 * lax.rsqrt(jnp.mean(x32 * x32, axis=-1, keepdims=True) + EPS)
    return (y * g.astype(F32)).astype(x.dtype)


def adaln_in(x, mod, j, g):
    h = rmsnorm(x, g).astype(F32)
    return (h * (1.0 + mod[:, 3 * j + 1, None]) + mod[:, 3 * j, None]).astype(x.dtype)


def adaln_out(x, y, mod, j, g, weight):
    return (x.astype(F32) + weight * mod[:, 3 * j + 2, None] * rmsnorm(y, g).astype(F32)).astype(x.dtype)


def swiglu(h, w_gate, w_up, w_down):
    return (jax.nn.silu(h @ w_gate) * (h @ w_up)) @ w_down


def s5_scan(u, lam_re, lam_im, log_dt, b_re, b_im, c_re, c_im, h0):
    lam = lax.complex(jnp.minimum(lam_re.astype(F32), -1e-4), lam_im.astype(F32))
    dt = jnp.exp(log_dt.astype(F32))[:, None]
    a_bar = jnp.exp(lam * dt)
    b = lax.complex(b_re.astype(F32), b_im.astype(F32))
    b_bar = ((a_bar - 1.0) / lam)[..., None] * b
    c = lax.complex(c_re.astype(F32), c_im.astype(F32))
    bu = jnp.einsum('nlgc,gpc->nlgp', u.astype(jnp.complex64), b_bar)
    bu = bu.at[:, 0].add(a_bar * h0)
    a = jnp.broadcast_to(a_bar, bu.shape)

    def combine(e1, e2):
        a1, b1 = e1
        a2, b2 = e2
        return a1 * a2, a2 * b1 + b2

    _, h = lax.associative_scan(combine, (a, bu), axis=1)
    y = jnp.real(jnp.einsum('nlgp,gcp->nlgc', h, c))
    return y, h[:, -1]


def s5_mixer(u, lam_re, lam_im, log_dt, b_re, b_im, c_re, c_im, d_skip, w_glu, b_glu, h0_re, h0_im):
    n, L, _ = u.shape
    u32 = u.astype(F32)
    ug = u32.reshape(n, L, S5_GROUPS, S5_GROUP)
    h0 = lax.complex(h0_re.astype(F32), h0_im.astype(F32))
    y_f, s_f = s5_scan(ug, lam_re[0], lam_im[0], log_dt[0], b_re[0], b_im[0], c_re[0], c_im[0], h0[:, 0])
    y_b, s_b = s5_scan(jnp.flip(ug, 1), lam_re[1], lam_im[1], log_dt[1], b_re[1], b_im[1], c_re[1], c_im[1], h0[:, 1])
    y = (y_f + jnp.flip(y_b, 1)).reshape(n, L, S5_WIDTH) + d_skip.astype(F32) * u32
    z = jax.nn.gelu(y)
    out = z * jax.nn.sigmoid(z @ w_glu.astype(F32) + b_glu.astype(F32))
    s_fin = jnp.stack([s_f, s_b], axis=1)
    return out.astype(u.dtype), jnp.real(s_fin), jnp.imag(s_fin)


def retention_scan(q, k, v, log_gamma, s0):
    n, L, H, dk = q.shape
    nc = L // RET_CHUNK
    qc = q.reshape(n, nc, RET_CHUNK, H, dk)
    kc = k.reshape(n, nc, RET_CHUNK, H, dk)
    vc = v.reshape(n, nc, RET_CHUNK, H, v.shape[-1])
    pos = jnp.arange(RET_CHUNK, dtype=F32)
    lg = log_gamma.astype(F32)[:, None]
    rel = pos[:, None] - pos[None, :]
    decay_mask = jnp.where(rel >= 0, jnp.exp(jnp.maximum(rel, 0.0)[None] * lg[:, :, None]), 0.0)
    inner = jnp.einsum('ncihd,ncjhd->nchij', qc, kc) * decay_mask
    o_inner = jnp.einsum('nchij,ncjhe->ncihe', inner, vc)
    k_dec = kc * jnp.exp((RET_CHUNK - 1.0 - pos)[None, :] * lg).T[None, None, :, :, None]
    kv = jnp.einsum('ncjhd,ncjhe->nchde', k_dec, vc)
    chunk_decay = jnp.exp(RET_CHUNK * lg)[..., None]

    def step(s, kv_c):
        return chunk_decay * s + kv_c, s

    s_final, s_start = lax.scan(step, s0, jnp.moveaxis(kv, 1, 0))
    s_start = jnp.moveaxis(s_start, 0, 1)
    q_dec = qc * jnp.exp((pos + 1.0)[None, :] * lg).T[None, None, :, :, None]
    o_cross = jnp.einsum('ncihd,nchde->ncihe', q_dec, s_start)
    return (o_inner + o_cross).reshape(n, L, H, -1), s_final


def retention_mixer(q, k, v, g, decay_logit, gn_g, s0):
    n, L, _ = q.shape
    q = q.astype(F32).reshape(n, L, RET_HEADS, RET_DK)
    k = k.astype(F32).reshape(n, L, RET_HEADS, RET_DK) * (RET_DK ** -0.5)
    v = v.astype(F32).reshape(n, L, RET_HEADS, RET_DV)
    lg = jax.nn.log_sigmoid(decay_logit.astype(F32))
    s0 = s0.astype(F32)
    o_f, s_f = retention_scan(q, k, v, lg[0], s0[:, 0])
    o_b, s_b = retention_scan(jnp.flip(q, 1), jnp.flip(k, 1), jnp.flip(v, 1), lg[1], s0[:, 1])
    o = o_f + jnp.flip(o_b, 1)
    mu = jnp.mean(o, axis=-1, keepdims=True)
    var = jnp.mean(jnp.square(o - mu), axis=-1, keepdims=True)
    o = ((o - mu) * lax.rsqrt(var + EPS)).reshape(n, L, RET_WIDTH) * gn_g.astype(F32)
    out = jax.nn.silu(g.astype(F32)) * o
    return out.astype(g.dtype), jnp.stack([s_f, s_b], axis=1)


def pool_mixer(u, w_pool, pool_scale):
    n, L, _ = u.shape
    u32 = u.astype(F32).reshape(n, L, POOL_GROUPS, POOL_GC)
    cs = jnp.concatenate([jnp.zeros_like(u32[:, :1]), jnp.cumsum(u32, axis=1)], axis=1)
    t = jnp.arange(L)
    outs = []
    for gi, w in enumerate(POOL_WINDOWS):
        lo = jnp.clip(t - w // 2, 0, L - 1)
        hi = jnp.clip(t + w // 2 - 1, 0, L - 1)
        cnt = (hi - lo + 1).astype(F32)
        mean = (cs[:, hi + 1, gi] - cs[:, lo, gi]) / cnt[None, :, None]
        outs.append(mean - u32[:, :, gi])
    pooled = jnp.stack(outs, axis=2)
    mixed = jnp.einsum('nlgc,gcd->nlgd', pooled, w_pool.astype(F32))
    return (mixed.reshape(n, L, POOL_WIDTH) * pool_scale.astype(F32)).astype(u.dtype)


def rope_axis(x, pos, n_freq):
    freqs = ROPE_BASE ** (-jnp.arange(n_freq, dtype=F32) / n_freq)
    ang = pos.astype(F32)[:, None] * freqs[None]
    cos = jnp.cos(ang)[None, :, None, :]
    sin = jnp.sin(ang)[None, :, None, :]
    x1, x2 = x[..., :n_freq], x[..., n_freq:]
    return jnp.concatenate([x1 * cos - x2 * sin, x1 * sin + x2 * cos], axis=-1)


def axial_rope(x):
    L = x.shape[1]
    n_rows = L // GRID_W
    rows = jnp.repeat(jnp.arange(n_rows), GRID_W)
    cols = jnp.tile(jnp.arange(GRID_W), n_rows)
    half = x.shape[-1] // 2
    return jnp.concatenate([rope_axis(x[..., :half], rows, half // 2),
                            rope_axis(x[..., half:], cols, half // 2)], axis=-1)


def attend_block(qb, k, v, mask, sink):
    s = jnp.einsum('nqkgd,nskd->nkgqs', qb, k) * (ATT_HD ** -0.5)
    if mask is not None:
        s = jnp.where(mask, s, NEG)
    sk = sink[None, :, :, None, None]
    m = jnp.maximum(jnp.max(s, axis=-1, keepdims=True), sk)
    p = jnp.exp(s - m)
    denom = jnp.sum(p, axis=-1, keepdims=True) + jnp.exp(sk - m)
    return jnp.einsum('nkgqs,nskd->nqkgd', p / denom, v)


def ctx_attention(q, k, v, sink):
    n, L = q.shape[:2]
    nb = L // ATT_BLOCK
    qb = jnp.moveaxis(q.reshape(n, nb, ATT_BLOCK, ATT_KV, ATT_GROUP, ATT_HD), 1, 0)
    o = lax.map(lambda qi: attend_block(qi, k, v, None, sink), qb)
    return jnp.moveaxis(o, 0, 1).reshape(n, L, ATT_HEADS * ATT_HD)


def latent_attention(q, k, v, k_ctx, v_ctx, sink):
    n, L = q.shape[:2]
    nb = L // ATT_BLOCK
    span = 3 * ATT_BLOCK
    qb = jnp.moveaxis(q.reshape(n, nb, ATT_BLOCK, ATT_KV, ATT_GROUP, ATT_HD), 1, 0)
    pad = ((0, 0), (ATT_BLOCK, ATT_BLOCK), (0, 0), (0, 0))
    kp = jnp.pad(k, pad)
    vp = jnp.pad(v, pad)
    q_off = jnp.arange(ATT_BLOCK)
    k_off = jnp.arange(span) - ATT_BLOCK
    band = jnp.abs(k_off[None, :] - q_off[:, None]) <= ATT_WIN
    ctx_mask = jnp.ones((ATT_BLOCK, k_ctx.shape[1]), dtype=bool)

    def block(args):
        i, qi = args
        start = i * ATT_BLOCK
        kb = lax.dynamic_slice_in_dim(kp, start, span, axis=1)
        vb = lax.dynamic_slice_in_dim(vp, start, span, axis=1)
        kpos = start + k_off
        mask = band & ((kpos >= 0) & (kpos < L))[None, :]
        keys = jnp.concatenate([kb, k_ctx], axis=1)
        vals = jnp.concatenate([vb, v_ctx], axis=1)
        return attend_block(qi, keys, vals, jnp.concatenate([mask, ctx_mask], axis=1), sink)

    o = lax.map(block, (jnp.arange(nb), qb))
    return jnp.moveaxis(o, 0, 1).reshape(n, L, ATT_HEADS * ATT_HD)


def trunk(x, cond, is_ctx, s5_re, s5_im, ret_state, ck, cv, W):
    (w_mod, b_mod, norm_g, ffn1_gate, ffn1_up, ffn1_down, ffn2_gate, ffn2_up, ffn2_down,
     even_w_in, even_w_out, s5_lam_re, s5_lam_im, s5_log_dt, s5_b_re, s5_b_im, s5_c_re, s5_c_im,
     s5_d, s5_glu_w, s5_glu_b, ret_decay_logit, ret_gn_g,
     odd_w_in, odd_w_out, pool_w, pool_scale, att_sink) = W
    n, L, _ = x.shape
    dt = x.dtype
    silu_c = jax.nn.silu(cond.astype(F32))
    out_re, out_im, out_ret, out_k, out_v = [], [], [], [], []
    for l in range(DEPTH):
        mod = (silu_c @ w_mod[l].astype(F32) + b_mod[l].astype(F32)).reshape(-1, N_MOD, D_MODEL)
        h = adaln_in(x, mod, 0, norm_g[l, 0])
        x = adaln_out(x, swiglu(h, ffn1_gate[l], ffn1_up[l], ffn1_down[l]), mod, 0, norm_g[l, 1], 0.5)
        h = adaln_in(x, mod, 1, norm_g[l, 2])
        if l % 2 == 0:
            e = l // 2
            proj = h @ even_w_in[e]
            u, q, k, v, g = jnp.split(proj, [S5_WIDTH, S5_WIDTH + RET_WIDTH, S5_WIDTH + 2 * RET_WIDTH,
                                             S5_WIDTH + 3 * RET_WIDTH], axis=-1)
            if is_ctx:
                h0_re = jnp.zeros((n, 2, S5_GROUPS, S5_P), F32)
                h0_im = jnp.zeros((n, 2, S5_GROUPS, S5_P), F32)
                r0 = jnp.zeros((n, 2, RET_HEADS, RET_DK, RET_DV), F32)
            else:
                h0_re, h0_im, r0 = s5_re[:, e], s5_im[:, e], ret_state[:, e]
            y_a, sr, si = s5_mixer(u, s5_lam_re[e], s5_lam_im[e], s5_log_dt[e], s5_b_re[e], s5_b_im[e],
                                   s5_c_re[e], s5_c_im[e], s5_d[e], s5_glu_w[e], s5_glu_b[e], h0_re, h0_im)
            y_b, rs = retention_mixer(q, k, v, g, ret_decay_logit[e], ret_gn_g[e], r0)
            y = jnp.concatenate([y_a, y_b], axis=-1) @ even_w_out[e]
            if is_ctx:
                out_re.append(sr)
                out_im.append(si)
                out_ret.append(rs)
        else:
            o = l // 2
            proj = h @ odd_w_in[o]
            u, q, k, v = jnp.split(proj, [POOL_WIDTH, POOL_WIDTH + ATT_HEADS * ATT_HD,
                                          POOL_WIDTH + (ATT_HEADS + ATT_KV) * ATT_HD], axis=-1)
            y_c = pool_mixer(u, pool_w[o], pool_scale[o])
            q = q.astype(F32).reshape(n, L, ATT_HEADS, ATT_HD)
            k = k.astype(F32).reshape(n, L, ATT_KV, ATT_HD)
            v = v.astype(F32).reshape(n, L, ATT_KV, ATT_HD)
            sink = att_sink[o].astype(F32).reshape(ATT_KV, ATT_GROUP)
            if is_ctx:
                y_d = ctx_attention(q, k, v, sink)
                out_k.append(k)
                out_v.append(v)
            else:
                y_d = latent_attention(axial_rope(q), axial_rope(k), v,
                                       ck[:, o].astype(F32), cv[:, o].astype(F32), sink)
            y = jnp.concatenate([y_c, y_d.astype(dt)], axis=-1) @ odd_w_out[o]
        x = adaln_out(x, y, mod, 1, norm_g[l, 3], 1.0)
        h = adaln_in(x, mod, 2, norm_g[l, 4])
        x = adaln_out(x, swiglu(h, ffn2_gate[l], ffn2_up[l], ffn2_down[l]), mod, 2, norm_g[l, 5], 0.5)
    if is_ctx:
        return (x, jnp.stack(out_re, axis=1), jnp.stack(out_im, axis=1), jnp.stack(out_ret, axis=1),
                jnp.stack(out_k, axis=1), jnp.stack(out_v, axis=1))
    return x


def setup_inputs(seed: int = 0) -> dict:
    key = jax.random.key(seed)
    ks = iter(jax.random.split(key, 48))

    def nrm(shape, scale):
        return jax.random.normal(next(ks), shape, F32) * scale

    D, F = D_MODEL, FFN_HIDDEN
    n_idx = jnp.arange(S5_P, dtype=F32)
    h_idx = jnp.arange(RET_HEADS, dtype=F32)
    ret_logit0 = jnp.log(2.0 ** (5.0 + h_idx) - 1.0)
    return {
        'x_prompt': nrm((BATCH, SEQ, D), 1.0),
        'x_sample': nrm((DEC_BATCH, DEC_SEQ, D), 1.0),
        'c': nrm((DEC_BATCH, D), 1.0),
        'state_s5_re': nrm((DEC_BATCH, N_EVEN, 2, S5_GROUPS, S5_P), 0.5),
        'state_s5_im': nrm((DEC_BATCH, N_EVEN, 2, S5_GROUPS, S5_P), 0.5),
        'state_ret': nrm((DEC_BATCH, N_EVEN, 2, RET_HEADS, RET_DK, RET_DV), 0.1),
        'cache_k': nrm((DEC_BATCH, N_ODD, PAST_LEN, ATT_KV, ATT_HD), 1.0),
        'cache_v': nrm((DEC_BATCH, N_ODD, PAST_LEN, ATT_KV, ATT_HD), 1.0),
        'c_ctx': nrm((D,), 1.0),
        'w_mod': nrm((DEPTH, D, N_MOD * D), 0.5 * D ** -0.5),
        'b_mod': nrm((DEPTH, N_MOD * D), 0.01),
        'norm_g': 1.0 + nrm((DEPTH, 6, D), 0.01),
        'ffn1_gate': nrm((DEPTH, D, F), D ** -0.5),
        'ffn1_up': nrm((DEPTH, D, F), D ** -0.5),
        'ffn1_down': nrm((DEPTH, F, D), F ** -0.5),
        'ffn2_gate': nrm((DEPTH, D, F), D ** -0.5),
        'ffn2_up': nrm((DEPTH, D, F), D ** -0.5),
        'ffn2_down': nrm((DEPTH, F, D), F ** -0.5),
        'even_w_in': nrm((N_EVEN, D, EVEN_IN), D ** -0.5),
        'even_w_out': nrm((N_EVEN, S5_WIDTH + RET_WIDTH, D), (S5_WIDTH + RET_WIDTH) ** -0.5),
        's5_lam_re': -0.5 + nrm((N_EVEN, 2, S5_GROUPS, S5_P), 0.01),
        's5_lam_im': math.pi * n_idx + nrm((N_EVEN, 2, S5_GROUPS, S5_P), 0.01),
        's5_log_dt': jnp.log(jax.random.uniform(next(ks), (N_EVEN, 2, S5_GROUPS), F32, 1e-3, 1e-1)),
        's5_b_re': nrm((N_EVEN, 2, S5_GROUPS, S5_P, S5_GROUP), (2 * S5_GROUP) ** -0.5),
        's5_b_im': nrm((N_EVEN, 2, S5_GROUPS, S5_P, S5_GROUP), (2 * S5_GROUP) ** -0.5),
        's5_c_re': nrm((N_EVEN, 2, S5_GROUPS, S5_GROUP, S5_P), (2 * S5_P) ** -0.5),
        's5_c_im': nrm((N_EVEN, 2, S5_GROUPS, S5_GROUP, S5_P), (2 * S5_P) ** -0.5),
        's5_d': nrm((N_EVEN, S5_WIDTH), 1.0),
        's5_glu_w': nrm((N_EVEN, S5_WIDTH, S5_WIDTH), S5_WIDTH ** -0.5),
        's5_glu_b': nrm((N_EVEN, S5_WIDTH), 0.01),
        'ret_decay_logit': ret_logit0 + nrm((N_EVEN, 2, RET_HEADS), 0.01),
        'ret_gn_g': 1.0 + nrm((N_EVEN, RET_WIDTH), 0.01),
        'odd_w_in': nrm((N_ODD, D, ODD_IN), D ** -0.5),
        'odd_w_out': nrm((N_ODD, POOL_WIDTH + ATT_HEADS * ATT_HD, D), (POOL_WIDTH + ATT_HEADS * ATT_HD) ** -0.5),
        'pool_w': nrm((N_ODD, POOL_GROUPS, POOL_GC, POOL_GC), POOL_GC ** -0.5),
        'pool_scale': 1.0 + nrm((N_ODD, POOL_WIDTH), 0.1),
        'att_sink': nrm((N_ODD, ATT_HEADS), 0.5),
    }


def reference(x_prompt, x_sample, c, state_s5_re, state_s5_im, state_ret, cache_k, cache_v, c_ctx,
              w_mod, b_mod, norm_g, ffn1_gate, ffn1_up, ffn1_down, ffn2_gate, ffn2_up, ffn2_down,
              even_w_in, even_w_out, s5_lam_re, s5_lam_im, s5_log_dt, s5_b_re, s5_b_im, s5_c_re, s5_c_im,
              s5_d, s5_glu_w, s5_glu_b, ret_decay_logit, ret_gn_g,
              odd_w_in, odd_w_out, pool_w, pool_scale, att_sink):
    W = (w_mod, b_mod, norm_g, ffn1_gate, ffn1_up, ffn1_down, ffn2_gate, ffn2_up, ffn2_down,
         even_w_in, even_w_out, s5_lam_re, s5_lam_im, s5_log_dt, s5_b_re, s5_b_im, s5_c_re, s5_c_im,
         s5_d, s5_glu_w, s5_glu_b, ret_decay_logit, ret_gn_g,
         odd_w_in, odd_w_out, pool_w, pool_scale, att_sink)
    y_prompt, new_s5_re, new_s5_im, new_ret, new_k, new_v = trunk(
        x_prompt, c_ctx[None, :], True, None, None, None, None, None, W)
    y_sample = trunk(x_sample, c, False, state_s5_re, state_s5_im, state_ret, cache_k, cache_v, W)
    return (y_prompt, y_sample, new_s5_re, new_s5_im, new_ret, new_k, new_v)
```

```cpp
#include <hip/hip_runtime.h>
#include <stdio.h>
#include <stdint.h>

#define LAS __attribute__((address_space(3)))
#define GAS __attribute__((address_space(1)))
typedef unsigned short bf16_t;
typedef short bf16x8 __attribute__((ext_vector_type(8)));
typedef short bf16x4 __attribute__((ext_vector_type(4)));
typedef float f32x4 __attribute__((ext_vector_type(4)));
typedef float f32x2 __attribute__((ext_vector_type(2)));
typedef unsigned u32x4 __attribute__((ext_vector_type(4)));
typedef unsigned u32x2 __attribute__((ext_vector_type(2)));

constexpr int D = 2048, FF = 5632, DEPTH = 4;
constexpr int NCTX = 4096, NDEC = 2048, MROWS = 6144;
constexpr int NMOD = 9;
constexpr int EVEN_IN = 5120, ODD_IN = 2560;
constexpr float EPS = 1e-6f;
#ifndef DBG_SCALE_V
#define DBG_SCALE_V 1.0f
#endif
constexpr float DBG_SCALE = DBG_SCALE_V;

constexpr size_t OUT_Y = 0;
constexpr size_t OUT_S5RE = (size_t)MROWS * D;
constexpr size_t OUT_S5IM = OUT_S5RE + 262144;
constexpr size_t OUT_RET = OUT_S5IM + 262144;
constexpr size_t OUT_K = OUT_RET + 8388608;
constexpr size_t OUT_V = OUT_K + 2097152;
constexpr size_t OUT_TOTAL = OUT_V + 2097152;

enum { I_XP = 0, I_XS, I_C, I_S5RE, I_S5IM, I_SRET, I_CK, I_CV, I_CCTX, I_WMOD, I_BMOD, I_NORMG, I_F1G, I_F1U, I_F1D, I_F2G, I_F2U, I_F2D,
       I_EWIN, I_EWOUT, I_LAMRE, I_LAMIM, I_LOGDT, I_BRE, I_BIM, I_CRE, I_CIM, I_S5D, I_GLUW, I_GLUB, I_DECAY, I_GNG, I_OWIN, I_OWOUT, I_POOLW, I_POOLS, I_SINK, N_IN };

constexpr size_t MiB = 1u << 20;
constexpr size_t WS_CTL = 0, CTL_ZERO_BYTES = 64 * 1024;
constexpr size_t WS_MOD = 1 * MiB;
constexpr size_t WS_ROPE = 2 * MiB;
constexpr size_t SZ_WGU = (size_t)2 * FF * D * 2, SZ_WD = (size_t)D * FF * 2;
constexpr size_t SZ_WIN_E = (size_t)EVEN_IN * D * 2, SZ_WIN_O = (size_t)ODD_IN * D * 2, SZ_WOUT = (size_t)D * D * 2, SZ_WGLU = (size_t)1024 * 1024 * 2, SZ_WPOOL = (size_t)1024 * 256 * 2;
constexpr size_t WS_W = 4 * MiB;
constexpr size_t SZ_LAYER_FFN = 2 * SZ_WGU + 2 * SZ_WD;
constexpr size_t SZ_LAYER = SZ_LAYER_FFN + SZ_WIN_E + SZ_WOUT + SZ_WGLU;
__host__ __device__ constexpr size_t ws_wgu(int l, int s) { return WS_W + (size_t)l * SZ_LAYER + (size_t)s * (SZ_WGU + SZ_WD); }
__host__ __device__ constexpr size_t ws_wd(int l, int s) { return ws_wgu(l, s) + SZ_WGU; }
__host__ __device__ constexpr size_t ws_win(int l) { return WS_W + (size_t)l * SZ_LAYER + SZ_LAYER_FFN; }
__host__ __device__ constexpr size_t ws_wout(int l) { return ws_win(l) + SZ_WIN_E; }
__host__ __device__ constexpr size_t ws_wx(int l) { return ws_wout(l) + SZ_WOUT; }
constexpr size_t WS_WEND = WS_W + 4 * SZ_LAYER;
constexpr size_t al(size_t x) { return (x + MiB - 1) / MiB * MiB; }
constexpr size_t WS_X = al(WS_WEND);
constexpr size_t WS_Y = WS_X + (size_t)MROWS * D * 4;
constexpr size_t WS_H = WS_Y + (size_t)MROWS * D * 4;
constexpr size_t WS_ACT = WS_H + (size_t)MROWS * D * 2;
constexpr size_t WS_PROJ = WS_ACT + (size_t)MROWS * FF * 2;
constexpr size_t WS_Z = WS_PROJ + (size_t)MROWS * EVEN_IN * 2;
constexpr size_t WS_YCAT = WS_Z + (size_t)MROWS * 1024 * 2;
constexpr size_t WS_SST = WS_YCAT + (size_t)MROWS * D * 2;
constexpr size_t WS_END = WS_SST + (size_t)96 * 64 * 2 * 128 * 4;

constexpr int RING_BYTES = 131072;
constexpr int MISC_OFF = RING_BYTES + 320;
constexpr int LDS_BYTES = 147456;
constexpr int NWAVES = 8;

__device__ __forceinline__ unsigned f2bf(float f) { return (unsigned)__builtin_bit_cast(unsigned short, (__bf16)f); }
typedef __bf16 hwbf16x2 __attribute__((ext_vector_type(2)));
__device__ __forceinline__ unsigned pk2(float lo, float hi) { const f32x2 v = {lo, hi}; return __builtin_bit_cast(unsigned, __builtin_convertvector(v, hwbf16x2)); }
__device__ __forceinline__ float bf2f(unsigned short b) { return __builtin_bit_cast(float, ((unsigned)b) << 16); }
__device__ __forceinline__ float bflo(unsigned w) { return __builtin_bit_cast(float, w << 16); }
__device__ __forceinline__ float bfhi(unsigned w) { return __builtin_bit_cast(float, w & 0xffff0000u); }
__device__ __forceinline__ float wave_sum(float v) {
#pragma unroll
    for (int o = 1; o < 64; o <<= 1) v += __shfl_xor(v, o);
    return v;
}
__device__ __forceinline__ float sigmoidf_(float x) { return __builtin_amdgcn_rcpf(1.0f + __expf(-x)); }
__device__ __forceinline__ float siluf_(float x) { return x * __builtin_amdgcn_rcpf(1.0f + __expf(-x)); }
__device__ __forceinline__ int lane_id() { int l; asm volatile("v_mbcnt_lo_u32_b32 %0, -1, 0\n\tv_mbcnt_hi_u32_b32 %0, -1, %0" : "=v"(l)); return l; }
__device__ __forceinline__ void st16_wt(void* p, u32x4 v) { asm volatile("global_store_dwordx4 %0, %1, off sc1\n\ts_nop 1" :: "v"(p), "v"(v) : "memory"); }
__device__ __forceinline__ void st16_wt(void* p, f32x4 v) { asm volatile("global_store_dwordx4 %0, %1, off sc1\n\ts_nop 1" :: "v"(p), "v"(v) : "memory"); }
__device__ __forceinline__ void st8_wt(void* p, u32x2 v) { asm volatile("global_store_dwordx2 %0, %1, off sc1\n\ts_nop 1" :: "v"(p), "v"(v) : "memory"); }
#define LDS_WAIT() asm volatile("s_waitcnt lgkmcnt(0)" ::: "memory")
#define VM_WAIT() asm volatile("s_waitcnt vmcnt(0)" ::: "memory")

namespace pg8 {
#define PG8_LAS __attribute__((address_space(3)))
constexpr int BM = 256, BK = 64, HALF = 128, HTB = HALF * BK * 2, STAGE_BYTES = 8 * HTB, NXCD = 8, WGM = 8;
__host__ __device__ __forceinline__ int lds_byte(int r, int c) { const int st = (r >> 4) * 2 + (c >> 5), rr = r & 15, cc = c & 31, ob = rr * 64 + cc * 2; return st * 1024 + (ob ^ (((ob >> 9) & 1) << 5)); }
__host__ __device__ __forceinline__ void stage_rc(int b, int& R, int& C) { const int st = b / 1024, sb = b % 1024, swz = sb ^ (((sb >> 9) & 1) << 5); R = (st >> 1) * 16 + swz / 64; C = (st & 1) * 32 + (swz % 64) / 2; }
__host__ __device__ __forceinline__ int perm32(int rho) { const int n = rho >> 4, i = rho & 15; return 8 * (i >> 2) + 4 * n + (i & 3); }

struct Unit { int pm, pn; };
struct Gemm { const bf16_t* A; const bf16_t* Bt; int M, N, K, lda, ldb, a_pn_off; };

struct StaticOrder {
    int nM, nN, nwg, G, c;
    __host__ __device__ void init(int M, int N, int G_, int c_, int bm = BM) { nM = M / bm; nN = N / BM; nwg = nM * nN; G = G_; c = c_; }
    __host__ __device__ bool next(int i, Unit& u) const {
        const long L = (long)i * G + c; if (L >= nwg) return false;
        int wgid = (int)L; { const int q = nwg / NXCD, r = nwg % NXCD, xcd = wgid % NXCD, off = wgid / NXCD; wgid = (xcd < r ? xcd * (q + 1) : r * (q + 1) + (xcd - r) * q) + off; }
        const int nig = WGM * nN, gid = wgid / nig, fm = gid * WGM, gsz = (nM - fm) < WGM ? (nM - fm) : WGM;
        u.pm = fm + ((wgid % nig) % gsz); u.pn = (wgid % nig) / gsz; return true;
    }
};

template <int MB, class Epi>
__device__ __forceinline__ void gemm_phase(PG8_LAS unsigned char* lds, const Gemm g, const StaticOrder& S, const Epi& E, int wave_s) {
    int tid_ = wave_s * 64 + lane_id(); asm volatile("" : "+v"(tid_));
    const int tid = tid_, wid = __builtin_amdgcn_readfirstlane(tid >> 6), lane = tid & 63, wr = wid >> 2, wc = wid & 3, fr = lane & 15, fq = lane >> 4;
    const int K = g.K, nt = K / BK;
    unsigned voffA[2], voffB[2];
#pragma unroll
    for (int i = 0; i < 2; ++i) { int R, C; stage_rc(tid * 16 + i * 8192, R, C); const int Rb = (R & ~31) + perm32(R & 31);
        voffA[i] = (unsigned)(R * g.lda + C) * 2u; voffB[i] = (unsigned)(Rb * g.ldb + C) * 2u; }
    const size_t kstep = (size_t)(BK * 2);
    const size_t hstepA = (size_t)(32 * MB) * g.lda * 2, hstepB = (size_t)HALF * g.ldb * 2;
    const size_t tstepA = 2 * hstepA, tstepB = 2 * hstepB;
    const unsigned ldsw = (unsigned)wid * 1024u;
    const int aoff = lds_byte(wr * 16 * MB + fr, fq * 8), boff = lds_byte(wc * 32 + fr, fq * 8);
#define PG8_SA(b, h) (((b) * 2 + (h)) * HTB)
#define PG8_SB(b, h) ((4 + (b) * 2 + (h)) * HTB)
#define PG8_STAGE(bufoff, gbase, voff) do { _Pragma("unroll") for (int _i = 0; _i < 2; ++_i) \
        __builtin_amdgcn_global_load_lds((const unsigned*)((const char*)(gbase) + (voff)[_i]), (PG8_LAS unsigned*)(lds + (bufoff) + ldsw + _i * 8192), 16, 0, 0); } while (0)
#define PG8_LDA(dst, b, h) do { _Pragma("unroll") for (int m = 0; m < MB; ++m) _Pragma("unroll") for (int k = 0; k < 2; ++k) dst[m][k] = *(const PG8_LAS bf16x8*)(lds + PG8_SA(b, h) + aoff + m * 2048 + k * 1024); } while (0)
#define PG8_LDB(dst, b, h) do { _Pragma("unroll") for (int n = 0; n < 2; ++n) _Pragma("unroll") for (int k = 0; k < 2; ++k) dst[n][k] = *(const PG8_LAS bf16x8*)(lds + PG8_SB(b, h) + boff + n * 2048 + k * 1024); } while (0)
#define PG8_MMA(ai, bj, At, Bt) do { __builtin_amdgcn_s_setprio(1); _Pragma("unroll") for (int m = 0; m < MB; ++m) _Pragma("unroll") for (int n = 0; n < 2; ++n) _Pragma("unroll") for (int k = 0; k < 2; ++k) \
        acc[ai][bj][m][n] = __builtin_amdgcn_mfma_f32_16x16x32_bf16(Bt[n][k], At[m][k], acc[ai][bj][m][n], 0, 0, 0); __builtin_amdgcn_s_setprio(0); } while (0)
#define PG8_WAIT_V(n) asm volatile("s_waitcnt vmcnt(" #n ")" ::: "memory")
#define PG8_WAIT_L(n) asm volatile("s_waitcnt lgkmcnt(" #n ")" ::: "memory")
#define PG8_BAR __builtin_amdgcn_s_barrier()
#define PG8_SCHED __builtin_amdgcn_sched_barrier(0)
    Unit cur, nxt; int ui = 0;
    if (!S.next(0, cur)) return;
    f32x4 acc[2][2][MB][2];
#pragma unroll
    for (int a = 0; a < 2; ++a)
#pragma unroll
        for (int b = 0; b < 2; ++b)
#pragma unroll
            for (int m = 0; m < MB; ++m)
#pragma unroll
                for (int n = 0; n < 2; ++n) acc[a][b][m][n] = (f32x4){0.f, 0.f, 0.f, 0.f};
    bf16x8 At[MB][2], B0[2][2], B1[2][2];
    const char* cA = (const char*)g.A + (size_t)cur.pm * tstepA + (size_t)cur.pn * g.a_pn_off * 2; const char* cB = (const char*)g.Bt + (size_t)cur.pn * tstepB;
    PG8_STAGE(PG8_SB(0, 0), cB, voffB); PG8_STAGE(PG8_SB(0, 1), cB + hstepB, voffB); PG8_STAGE(PG8_SA(0, 0), cA, voffA); PG8_STAGE(PG8_SA(0, 1), cA + hstepA, voffA);
    if (wr == 1) PG8_BAR;
    PG8_WAIT_V(2); PG8_BAR;
    PG8_STAGE(PG8_SB(1, 0), cB + kstep, voffB); PG8_STAGE(PG8_SA(1, 0), cA + kstep, voffA); PG8_STAGE(PG8_SB(1, 1), cB + hstepB + kstep, voffB);
    PG8_WAIT_V(6); PG8_BAR;
    for (;;) {
        const bool has_next = S.next(ui + 1, nxt);
        const char* nA = has_next ? (const char*)g.A + (size_t)nxt.pm * tstepA + (size_t)nxt.pn * g.a_pn_off * 2 : cA; const char* nB = has_next ? (const char*)g.Bt + (size_t)nxt.pn * tstepB : cB;
        for (int t = 0; t < nt; t += 2) {
            const bool last = (t == nt - 2);
            const char* a1 = cA + (size_t)(t + 1) * kstep;
            const char* a2 = last ? nA : cA + (size_t)(t + 2) * kstep; const char* b2 = last ? nB : cB + (size_t)(t + 2) * kstep;
            const char* a3 = a2 + kstep; const char* b3 = b2 + kstep;
            PG8_LDB(B0, 0, 0); PG8_LDB(B1, 0, 1); PG8_SCHED; PG8_LDA(At, 0, 0); PG8_STAGE(PG8_SA(1, 1), a1 + hstepA, voffA);
            PG8_WAIT_V(8); PG8_WAIT_L(0); PG8_BAR; PG8_MMA(0, 0, At, B0); PG8_MMA(0, 1, At, B1); PG8_BAR; PG8_SCHED;
            PG8_LDA(At, 0, 1); PG8_STAGE(PG8_SB(0, 0), b2, voffB); PG8_STAGE(PG8_SB(0, 1), b2 + hstepB, voffB); PG8_STAGE(PG8_SA(0, 0), a2, voffA);
            PG8_WAIT_V(8); PG8_WAIT_L(0); PG8_BAR; PG8_MMA(1, 0, At, B0); PG8_MMA(1, 1, At, B1); PG8_BAR; PG8_SCHED;
            PG8_LDB(B0, 1, 0); PG8_LDB(B1, 1, 1); PG8_SCHED; PG8_LDA(At, 1, 0); PG8_STAGE(PG8_SA(0, 1), a2 + hstepA, voffA);
            PG8_WAIT_V(8); PG8_WAIT_L(0); PG8_BAR; PG8_MMA(0, 0, At, B0); PG8_MMA(0, 1, At, B1); PG8_BAR; PG8_SCHED;
            PG8_LDA(At, 1, 1); PG8_STAGE(PG8_SB(1, 0), b3, voffB); PG8_STAGE(PG8_SB(1, 1), b3 + hstepB, voffB); PG8_STAGE(PG8_SA(1, 0), a3, voffA);
            PG8_WAIT_V(8); PG8_WAIT_L(0); PG8_BAR; PG8_MMA(1, 0, At, B0); PG8_MMA(1, 1, At, B1); PG8_BAR; PG8_SCHED;
        }
        if (wr == 0) PG8_BAR;
        E(acc, cur, wr, wc, fr, fq);
        if (!has_next) break;
#pragma unroll
        for (int a = 0; a < 2; ++a)
#pragma unroll
            for (int b = 0; b < 2; ++b)
#pragma unroll
                for (int m = 0; m < MB; ++m)
#pragma unroll
                    for (int n = 0; n < 2; ++n) acc[a][b][m][n] = (f32x4){0.f, 0.f, 0.f, 0.f};
        cur = nxt; cA = nA; cB = nB; ++ui;
        if (wr == 1) PG8_BAR;
    }
    PG8_WAIT_V(0);
    PG8_BAR;
#undef PG8_SA
#undef PG8_SB
#undef PG8_STAGE
#undef PG8_LDA
#undef PG8_LDB
#undef PG8_MMA
#undef PG8_WAIT_V
#undef PG8_WAIT_L
#undef PG8_BAR
#undef PG8_SCHED
}
}

struct EpiF32 {
    float* C; int ldc;
    template <int MB> __device__ __forceinline__ void operator()(const f32x4 (&acc)[2][2][MB][2], const pg8::Unit& u, int wr, int wc, int fr, int fq) const {
        const int row0 = u.pm * (64 * MB) + wr * (16 * MB) + fr, col0 = u.pn * 256 + wc * 32 + 8 * fq;
#pragma unroll
        for (int ai = 0; ai < 2; ++ai)
#pragma unroll
            for (int m = 0; m < MB; ++m) { float* rowp = C + (size_t)(row0 + ai * (32 * MB) + m * 16) * ldc + col0;
#pragma unroll
                for (int bj = 0; bj < 2; ++bj) { *(f32x4*)(rowp + bj * 128) = acc[ai][bj][m][0]; *(f32x4*)(rowp + bj * 128 + 4) = acc[ai][bj][m][1]; } }
    }
};
struct EpiSwiglu {
    bf16_t* O;
    template <int MB> __device__ __forceinline__ void operator()(const f32x4 (&acc)[2][2][MB][2], const pg8::Unit& u, int wr, int wc, int fr, int fq) const {
        const int row0 = u.pm * (64 * MB) + wr * (16 * MB) + fr, col0 = u.pn * 128 + wc * 32 + 8 * fq;
#pragma unroll
        for (int ai = 0; ai < 2; ++ai)
#pragma unroll
            for (int m = 0; m < MB; ++m) { bf16_t* rowp = O + (size_t)(row0 + ai * (32 * MB) + m * 16) * FF + col0;
                const f32x4 g0 = acc[ai][0][m][0], g1 = acc[ai][0][m][1], u0 = acc[ai][1][m][0], u1 = acc[ai][1][m][1];
                u32x4 w; w.x = pk2(siluf_(g0[0]) * u0[0], siluf_(g0[1]) * u0[1]); w.y = pk2(siluf_(g0[2]) * u0[2], siluf_(g0[3]) * u0[3]);
                w.z = pk2(siluf_(g1[0]) * u1[0], siluf_(g1[1]) * u1[1]); w.w = pk2(siluf_(g1[2]) * u1[2], siluf_(g1[3]) * u1[3]);
                st16_wt(rowp, w); }
    }
};
template <int MODE> struct EpiBf16 {
    bf16_t* O; int ldc; float* outk; float* outv; int o;
    template <int MB> __device__ __forceinline__ void operator()(const f32x4 (&acc)[2][2][MB][2], const pg8::Unit& u, int wr, int wc, int fr, int fq) const {
        const int row0 = u.pm * (64 * MB) + wr * (16 * MB) + fr, col0 = u.pn * 256 + wc * 32 + 8 * fq;
#pragma unroll
        for (int ai = 0; ai < 2; ++ai)
#pragma unroll
            for (int m = 0; m < MB; ++m) { const int row = row0 + ai * (32 * MB) + m * 16; bf16_t* rowp = O + (size_t)row * ldc + col0;
#pragma unroll
                for (int bj = 0; bj < 2; ++bj) { const f32x4 v0 = acc[ai][bj][m][0], v1 = acc[ai][bj][m][1];
                    u32x4 w; w.x = pk2(v0[0], v0[1]); w.y = pk2(v0[2], v0[3]); w.z = pk2(v1[0], v1[1]); w.w = pk2(v1[2], v1[3]);
                    st16_wt(rowp + bj * 128, w);
                    if (MODE == 1) { if (u.pn >= 8 && row < NCTX) { float* dst = (u.pn == 8 ? outk : outv) + ((size_t)((row >> 8) * 2 + o) * 256 + (row & 255)) * 256 + (col0 - u.pn * 256) + bj * 128;
                        *(f32x4*)dst = DBG_SCALE * v0; *(f32x4*)(dst + 4) = DBG_SCALE * v1; } } } }
    }
};
template <int MODE> struct EpiMix {
    bf16_t* O; const bf16_t* Zb; const float* vec;
    template <int MB> __device__ __forceinline__ void operator()(const f32x4 (&acc)[2][2][MB][2], const pg8::Unit& u, int wr, int wc, int fr, int fq) const {
        const int row0 = u.pm * (64 * MB) + wr * (16 * MB) + fr, col0 = u.pn * 256 + wc * 32 + 8 * fq;
        f32x4 bv[2][2];
#pragma unroll
        for (int bj = 0; bj < 2; ++bj) { bv[bj][0] = *(const f32x4*)(vec + col0 + bj * 128); bv[bj][1] = *(const f32x4*)(vec + col0 + bj * 128 + 4); }
#pragma unroll
        for (int ai = 0; ai < 2; ++ai)
#pragma unroll
            for (int m = 0; m < MB; ++m) { const int row = row0 + ai * (32 * MB) + m * 16; bf16_t* rowp = O + (size_t)row * 2048 + col0;
#pragma unroll
                for (int bj = 0; bj < 2; ++bj) { f32x4 v0 = acc[ai][bj][m][0], v1 = acc[ai][bj][m][1];
                    if (MODE == 0) { const u32x4 zz = *(const u32x4*)(Zb + (size_t)row * 1024 + col0 + bj * 128);
                        v0 += bv[bj][0]; v1 += bv[bj][1];
                        v0[0] = bflo(zz.x) * sigmoidf_(v0[0]); v0[1] = bfhi(zz.x) * sigmoidf_(v0[1]); v0[2] = bflo(zz.y) * sigmoidf_(v0[2]); v0[3] = bfhi(zz.y) * sigmoidf_(v0[3]);
                        v1[0] = bflo(zz.z) * sigmoidf_(v1[0]); v1[1] = bfhi(zz.z) * sigmoidf_(v1[1]); v1[2] = bflo(zz.w) * sigmoidf_(v1[2]); v1[3] = bfhi(zz.w) * sigmoidf_(v1[3]); }
                    else { v0 *= bv[bj][0]; v1 *= bv[bj][1]; }
                    u32x4 w; w.x = pk2(v0[0], v0[1]); w.y = pk2(v0[2], v0[3]); w.z = pk2(v1[0], v1[1]); w.w = pk2(v1[2], v1[3]);
                    st16_wt(rowp + bj * 128, w); } }
    }
};

#define XB_TMO      128
#define XB_XCNT(j)  (256  + 64 * (j))
#define XB_XSUB(j)  (1280 + 64 * (j))
#define XB_XGEN(j)  (2304 + 64 * (j))
#define XB_TOP      3328
#define XB_TOPGEN   3392
#define XCD_BAR_WORDS 3456
#define XB_SPIN_CAP (1u << 18)
__device__ __forceinline__ unsigned xb_ld(unsigned* p)              { return __hip_atomic_load(p, __ATOMIC_RELAXED, __HIP_MEMORY_SCOPE_AGENT); }
__device__ __forceinline__ unsigned xb_add(unsigned* p, unsigned v) { return __hip_atomic_fetch_add(p, v, __ATOMIC_RELAXED, __HIP_MEMORY_SCOPE_AGENT); }
__device__ __forceinline__ unsigned xb_xcc_id() { return (unsigned)__builtin_amdgcn_s_getreg((3 << 11) | 20) & 0xFu; }
#define XB_SPIN(cond, bar) do { unsigned _sp = 0; while (cond) { __builtin_amdgcn_s_sleep(1); \
    if ((++_sp & 255u) == 0u) { if (xb_ld(&(bar)[XB_TMO])) break; if (_sp > XB_SPIN_CAP) { atomicAdd(&(bar)[XB_TMO], 1u); break; } } } } while (0)
struct XcdBarrier { unsigned* bar; unsigned x; volatile LAS unsigned* st; };
__device__ __forceinline__ XcdBarrier xcd_barrier_post(unsigned* bar, volatile LAS unsigned* st) {
    XcdBarrier b; b.bar = bar; b.x = xb_xcc_id(); b.st = st;
    if (threadIdx.x == 0) (void)xb_add(&bar[XB_XCNT(b.x)], 1u);
    return b;
}
__device__ __forceinline__ void xcd_barrier_complete(unsigned* bar, unsigned x, unsigned& nloc, unsigned& nx) {
    const unsigned G = gridDim.x * gridDim.y * gridDim.z;
    unsigned sum, cnt, mine, sp = 0u;
    for (;;) {
        sum = 0u; cnt = 0u; mine = 0u;
#pragma unroll
        for (unsigned j = 0; j < 16; ++j) { const unsigned c = xb_ld(&bar[XB_XCNT(j)]); sum += c; cnt += (c > 0u) ? 1u : 0u; mine = (j == x) ? c : mine; }
        if (sum == G) break;
        __builtin_amdgcn_s_sleep(1);
        if ((++sp & 255u) == 0u) { if (xb_ld(&bar[XB_TMO])) break; if (sp > XB_SPIN_CAP) { atomicAdd(&bar[XB_TMO], 1u); break; } }
    }
    nloc = mine > 0u ? mine : 1u; nx = cnt > 0u ? cnt : 1u;
}
__device__ __forceinline__ void xcd_barrier(const XcdBarrier& b, int wave_s) {
    asm volatile("s_waitcnt vmcnt(0)" ::: "memory");
    __syncthreads();
    if (wave_s == 0 && lane_id() == 0) {
        unsigned* bar = b.bar; unsigned bx = b.x; asm volatile("" : "+s"(bar), "+s"(bx));
        __builtin_amdgcn_s_waitcnt(0);
        unsigned nloc = b.st[0], nx = b.st[1];
        if (nloc == 0u) { xcd_barrier_complete(bar, bx, nloc, nx); b.st[0] = nloc; b.st[1] = nx; }
        const unsigned old = xb_add(&bar[XB_XSUB(bx)], 1u);
        const unsigned gen = old / nloc;
        if (old + 1u == (gen + 1u) * nloc) {
            __builtin_amdgcn_fence(__ATOMIC_RELEASE, "agent");
            asm volatile("s_waitcnt vmcnt(0)" ::: "memory");
            const unsigned og = xb_add(&bar[XB_TOP], 1u);
            const unsigned tg = og / nx;
            if (og + 1u == (tg + 1u) * nx) xb_add(&bar[XB_TOPGEN], 1u);
            else XB_SPIN(xb_ld(&bar[XB_TOPGEN]) == tg, bar);
            __builtin_amdgcn_fence(__ATOMIC_ACQUIRE, "agent");
            xb_add(&bar[XB_XGEN(bx)], 1u);
            asm volatile("s_waitcnt vmcnt(0)" ::: "memory");
        } else {
            XB_SPIN(xb_ld(&bar[XB_XGEN(bx)]) == gen, bar);
            __builtin_amdgcn_fence(__ATOMIC_ACQUIRE, "agent");
            asm volatile("s_waitcnt vmcnt(0)" ::: "memory");
        }
    }
    __syncthreads();
}

struct Args { const float* in[N_IN]; float* out; unsigned char* ws; int ph_lo, ph_hi; };
struct Frame {
    LAS unsigned char* lds;
    int tid, lane, wave, G, gw, NGW;
    const float* const* in;
    float* out; unsigned char* ws;
};
__device__ __forceinline__ Frame refresh(const Frame& F0) {
    Frame F = F0; int ln = lane_id(); asm volatile("" : "+v"(ln));
    F.lane = ln; F.tid = F0.wave * 64 + ln; F.gw = blockIdx.x * NWAVES + F0.wave;
    return F;
}

struct ConvJob { int in_idx; unsigned src_off; int K, N; unsigned long long dst_off; int ldd; int map; int row_off; };
constexpr int NJOBS = 4 * 6 + 2 * 3 + 2 * 6;
struct ConvTable { ConvJob j[NJOBS]; int cum[NJOBS + 1]; };
constexpr ConvTable make_conv_table() {
    ConvTable t{}; int n = 0;
    for (int l = 0; l < DEPTH; ++l) {
        for (int s = 0; s < 2; ++s) {
            const int ig = s ? I_F2G : I_F1G, iu = s ? I_F2U : I_F1U, id = s ? I_F2D : I_F1D;
            t.j[n++] = ConvJob{ig, (unsigned)((size_t)l * D * FF), D, FF, ws_wgu(l, s), D, 1, 0};
            t.j[n++] = ConvJob{iu, (unsigned)((size_t)l * D * FF), D, FF, ws_wgu(l, s), D, 2, 0};
            t.j[n++] = ConvJob{id, (unsigned)((size_t)l * FF * D), FF, D, ws_wd(l, s), FF, 0, 0};
        }
        const int e = l >> 1;
        if ((l & 1) == 0) {
            t.j[n++] = ConvJob{I_EWIN, (unsigned)((size_t)e * D * EVEN_IN), D, EVEN_IN, ws_win(l), D, 0, 0};
            t.j[n++] = ConvJob{I_EWOUT, (unsigned)((size_t)e * D * D), D, D, ws_wout(l), D, 0, 0};
            t.j[n++] = ConvJob{I_GLUW, (unsigned)((size_t)e * 1024 * 1024), 1024, 1024, ws_wx(l), 1024, 0, 0};
        } else {
            t.j[n++] = ConvJob{I_OWIN, (unsigned)((size_t)e * D * ODD_IN), D, ODD_IN, ws_win(l), D, 0, 0};
            t.j[n++] = ConvJob{I_OWOUT, (unsigned)((size_t)e * D * D), D, D, ws_wout(l), D, 0, 0};
            for (int g = 0; g < 4; ++g) t.j[n++] = ConvJob{I_POOLW, (unsigned)((size_t)(e * 4 + g) * 256 * 256), 256, 256, ws_wx(l), 256, 0, g * 256};
        }
    }
    int c = 0;
    for (int i = 0; i < NJOBS; ++i) { t.cum[i] = c; c += (t.j[i].K / 64) * (t.j[i].N / 64); }
    t.cum[NJOBS] = c;
    return t;
}
__device__ const ConvTable g_conv = make_conv_table();

__device__ __forceinline__ void conv_tile(const float* src, int N, int k0, int n0, bf16_t* dst, int ldd, int drow0, LAS unsigned char* scr, int lane) {
    f32x4 v[16];
    const GAS float* sp = (const GAS float*)src + (size_t)(k0 + 2 * (lane >> 4)) * N + n0 + 4 * (lane & 15);
#pragma unroll
    for (int i = 0; i < 16; ++i) v[i] = __builtin_nontemporal_load((const GAS f32x4*)(sp + (size_t)((i & 1) + 8 * (i >> 1)) * N));
#pragma unroll
    for (int i = 0; i < 16; i += 2) { const int k = 2 * (lane >> 4) + 8 * (i >> 1);
#pragma unroll
        for (int j = 0; j < 4; ++j) { const int n = 4 * (lane & 15) + j; *(LAS unsigned*)(scr + n * 144 + k * 2) = pk2(v[i][j], v[i + 1][j]); } }
    LDS_WAIT();
#pragma unroll
    for (int i = 0; i < 8; ++i) { const int q = lane + 64 * i, n = q >> 3, c = q & 7;
        const u32x4 w = *(const LAS u32x4*)(scr + n * 144 + c * 16);
        __builtin_nontemporal_store(w, (GAS u32x4*)((GAS bf16_t*)dst + (size_t)(drow0 + n) * ldd + k0 + 8 * c)); }
    LDS_WAIT();
}

__device__ __forceinline__ void phase_convert(const Frame& F0) {
    const Frame F = refresh(F0);
    LAS unsigned char* scr = F.lds + F.wave * 9216;
    const int total = g_conv.cum[NJOBS];
    int j = 0;
    for (int t = F.gw; t < total; t += F.NGW) {
        while (t >= g_conv.cum[j + 1]) ++j;
        const ConvJob jb = g_conv.j[j];
        const int r = t - g_conv.cum[j], nbN = jb.N >> 6, kb = r / nbN, nb = r - kb * nbN, n0 = nb * 64;
        const int drow0 = jb.map == 0 ? jb.row_off + n0 : (256 * (n0 >> 7) + (n0 & 127) + (jb.map == 2 ? 128 : 0));
        conv_tile(F.in[jb.in_idx] + jb.src_off, jb.N, kb * 64, n0, (bf16_t*)(F.ws + jb.dst_off), jb.ldd, drow0, scr, F.lane);
    }
}

__device__ __forceinline__ void phase_mod(const Frame& F0) {
    const Frame F = refresh(F0);
    LAS float* sc = (LAS float*)(F.lds + 73728);
    LAS float* red = (LAS float*)(F.lds + 73728 + 24576);
    const float* cctx = F.in[I_CCTX]; const float* cdec = F.in[I_C];
    for (int idx = F.tid; idx < 3 * D; idx += 512) { const int set = idx >> 11, k = idx & 2047; const float v = set == 0 ? cctx[k] : cdec[(set - 1) * D + k]; sc[idx] = v / (1.0f + __expf(-v)); }
    __syncthreads();
    float* MOD = (float*)(F.ws + WS_MOD);
    for (int item = blockIdx.x; item < 256; item += F.G) {
        const int l = item >> 6, col0 = (item & 63) * 288;
        if (F.tid < 504) {
            const int cg = F.tid % 72, kg = F.tid / 72;
            f32x4 a0 = {0.f, 0.f, 0.f, 0.f}, a1 = a0, a2 = a0;
            const float* W = F.in[I_WMOD] + (size_t)l * D * (NMOD * D) + col0 + cg * 4;
#pragma unroll 8
            for (int k = kg; k < D; k += 7) { const f32x4 w = *(const f32x4*)(W + (size_t)k * (NMOD * D)); a0 += sc[k] * w; a1 += sc[2048 + k] * w; a2 += sc[4096 + k] * w; }
            LAS float* rp = red + (kg * 72 + cg) * 12;
            *(LAS f32x4*)rp = a0; *(LAS f32x4*)(rp + 4) = a1; *(LAS f32x4*)(rp + 8) = a2;
        }
        __syncthreads();
        for (int o = F.tid; o < 864; o += 512) { const int set = o / 288, cc = o % 288, cg = cc >> 2, jj = cc & 3; float s = F.in[I_BMOD][(size_t)l * (NMOD * D) + col0 + cc];
#pragma unroll
            for (int kg = 0; kg < 7; ++kg) s += red[(kg * 72 + cg) * 12 + set * 4 + jj];
            MOD[(size_t)(l * 3 + set) * (NMOD * D) + col0 + cc] = s; }
        __syncthreads();
    }
    if (blockIdx.x == 0) { float* rt = (float*)(F.ws + WS_ROPE);
        for (int idx = F.tid; idx < 2048; idx += 512) { const int pos = idx >> 5, i = idx & 31; const float fr = powf(10000.0f, -(float)i / 32.0f); const float ang = (float)pos * fr;
            rt[idx] = cosf(ang); rt[2048 + idx] = sinf(ang); } }
}

template <bool XIN_BF, bool XOUT_BF>
__device__ __forceinline__ void norm_phase(const Frame& F0, bool has_post, int l_post, int j_post, float wpost, bool has_pre, int l_pre, int j_pre,
                                           const void* xs_ctx, const void* xs_dec, void* xdst, bool store_x = true) {
    const Frame F = refresh(F0);
    const float* MOD = (const float*)(F.ws + WS_MOD); const bf16_t* Yb = (const bf16_t*)(F.ws + WS_Y); bf16_t* Hb = (bf16_t*)(F.ws + WS_H);
    const float* ng = F.in[I_NORMG];
    for (int row = F.gw; row < MROWS; row += F.NGW) {
        const int set = row < NCTX ? 0 : 1 + ((row - NCTX) >> 10);
        f32x4 x[8];
        if (XIN_BF) { const GAS bf16_t* xr = row < NCTX ? (const GAS bf16_t*)xs_ctx + (size_t)row * D : (const GAS bf16_t*)xs_dec + (size_t)(row - NCTX) * D;
#pragma unroll
            for (int j = 0; j < 8; ++j) { const u32x2 xw = *(const GAS u32x2*)(xr + 4 * F.lane + 256 * j); x[j] = (f32x4){bflo(xw.x), bfhi(xw.x), bflo(xw.y), bfhi(xw.y)}; } }
        else { const GAS float* xr = row < NCTX ? (const GAS float*)xs_ctx + (size_t)row * D : (const GAS float*)xs_dec + (size_t)(row - NCTX) * D;
#pragma unroll
            for (int j = 0; j < 8; ++j) x[j] = *(const GAS f32x4*)(xr + 4 * F.lane + 256 * j); }
        if (has_post) {
            f32x4 y[8]; float ss = 0.f;
#pragma unroll
            for (int j = 0; j < 8; ++j) { const u32x2 yw = *(const u32x2*)(Yb + (size_t)row * D + 4 * F.lane + 256 * j); y[j] = (f32x4){bflo(yw.x), bfhi(yw.x), bflo(yw.y), bfhi(yw.y)}; ss += (y[j][0] * y[j][0] + y[j][1] * y[j][1]) + (y[j][2] * y[j][2] + y[j][3] * y[j][3]); }
            const float ry = rsqrtf(wave_sum(ss) * (1.0f / D) + EPS);
            const float* gate = MOD + (size_t)((l_post * 3 + set) * NMOD + 3 * j_post + 2) * D; const float* gp = ng + (size_t)(l_post * 6 + 2 * j_post + 1) * D;
#pragma unroll
            for (int j = 0; j < 8; ++j) { const f32x4 gt = *(const f32x4*)(gate + 4 * F.lane + 256 * j), gg = *(const f32x4*)(gp + 4 * F.lane + 256 * j);
                x[j] += wpost * gt * ((y[j] * ry) * gg); }
        }
        if (store_x) {
            if (XOUT_BF) {
#pragma unroll
                for (int j = 0; j < 8; ++j) { u32x2 w; w.x = pk2(x[j][0], x[j][1]); w.y = pk2(x[j][2], x[j][3]); st8_wt((bf16_t*)xdst + (size_t)row * D + 4 * F.lane + 256 * j, w); }
            } else {
#pragma unroll
                for (int j = 0; j < 8; ++j) st16_wt((float*)xdst + (size_t)row * D + 4 * F.lane + 256 * j, x[j]); } }
        if (has_pre) {
            float ss = 0.f;
#pragma unroll
            for (int j = 0; j < 8; ++j) ss += (x[j][0] * x[j][0] + x[j][1] * x[j][1]) + (x[j][2] * x[j][2] + x[j][3] * x[j][3]);
            const float rx = rsqrtf(wave_sum(ss) * (1.0f / D) + EPS);
            const float* sh = MOD + (size_t)((l_pre * 3 + set) * NMOD + 3 * j_pre) * D; const float* scl = sh + D; const float* gp = ng + (size_t)(l_pre * 6 + 2 * j_pre) * D;
#pragma unroll
            for (int j = 0; j < 8; ++j) { const f32x4 s0 = *(const f32x4*)(sh + 4 * F.lane + 256 * j), s1 = *(const f32x4*)(scl + 4 * F.lane + 256 * j), gg = *(const f32x4*)(gp + 4 * F.lane + 256 * j);
                const f32x4 h = ((x[j] * rx) * gg) * (1.0f + s1) + s0;
                u32x2 w; w.x = pk2(h[0], h[1]); w.y = pk2(h[2], h[3]);
                st8_wt(Hb + (size_t)row * D + 4 * F.lane + 256 * j, w); }
        }
    }
}

struct S5Par { f32x2 a; f32x2 b[16]; };
__device__ __forceinline__ void s5_load_par(const Frame& F, int e, int dir, int g, S5Par& P, f32x2& a64) {
    const int p = F.lane; const size_t gi = (size_t)((e * 2 + dir) * 64 + g);
    float lr = F.in[I_LAMRE][gi * 64 + p]; lr = fminf(lr, -1e-4f); const float li = F.in[I_LAMIM][gi * 64 + p];
    const float dt = __expf(F.in[I_LOGDT][gi]);
    const float mag = __expf(lr * dt); float tt = li * dt * 0.15915494309189535f; tt -= rintf(tt);
    const float are = mag * __builtin_amdgcn_cosf(tt), aim = mag * __builtin_amdgcn_sinf(tt);
    P.a = (f32x2){are, aim};
    const float nr = are - 1.0f, ni = aim, den = 1.0f / (lr * lr + li * li);
    const float sr = (nr * lr + ni * li) * den, si = (ni * lr - nr * li) * den;
    const float* br = F.in[I_BRE] + (gi * 64 + p) * 16; const float* bi = F.in[I_BIM] + (gi * 64 + p) * 16;
#pragma unroll
    for (int q = 0; q < 4; ++q) { const f32x4 r4 = *(const f32x4*)(br + 4 * q), i4 = *(const f32x4*)(bi + 4 * q);
#pragma unroll
        for (int j = 0; j < 4; ++j) P.b[4 * q + j] = (f32x2){sr * r4[j] - si * i4[j], sr * i4[j] + si * r4[j]}; }
    float xr = are, xi = aim;
#pragma unroll
    for (int s = 0; s < 6; ++s) { const float t2 = xr * xr - xi * xi; xi = 2.0f * xr * xi; xr = t2; }
    a64 = (f32x2){xr, xi};
}
__device__ __forceinline__ void s5_stage_u(const Frame& F, int sp, int g, LAS float* ub) {
    const bf16_t* src = (const bf16_t*)(F.ws + WS_PROJ) + (size_t)(sp * 64 + F.lane) * EVEN_IN + g * 16;
    const u32x4 w0 = *(const u32x4*)src, w1 = *(const u32x4*)(src + 8);
    LAS f32x4* d = (LAS f32x4*)(ub + F.lane * 16);
    d[0] = (f32x4){bflo(w0.x), bfhi(w0.x), bflo(w0.y), bfhi(w0.y)}; d[1] = (f32x4){bflo(w0.z), bfhi(w0.z), bflo(w0.w), bfhi(w0.w)};
    d[2] = (f32x4){bflo(w1.x), bfhi(w1.x), bflo(w1.y), bfhi(w1.y)}; d[3] = (f32x4){bflo(w1.z), bfhi(w1.z), bflo(w1.w), bfhi(w1.w)};
    LDS_WAIT();
}
__device__ __forceinline__ void s5_bu4(const S5Par& P, const LAS float* ub0, int stepf, f32x2 (&bu)[4]) {
    f32x4 u[4][4];
#pragma unroll
    for (int q = 0; q < 4; ++q) { const LAS f32x4* up = (const LAS f32x4*)(ub0 + q * stepf); u[q][0] = up[0]; u[q][1] = up[1]; u[q][2] = up[2]; u[q][3] = up[3]; }
#pragma unroll
    for (int q = 0; q < 4; ++q) {
        f32x2 s0 = P.b[0] * u[q][0][0], s1 = P.b[1] * u[q][0][1], s2 = P.b[2] * u[q][0][2], s3 = P.b[3] * u[q][0][3];
        s0 += P.b[4] * u[q][1][0]; s1 += P.b[5] * u[q][1][1]; s2 += P.b[6] * u[q][1][2]; s3 += P.b[7] * u[q][1][3];
        s0 += P.b[8] * u[q][2][0]; s1 += P.b[9] * u[q][2][1]; s2 += P.b[10] * u[q][2][2]; s3 += P.b[11] * u[q][2][3];
        s0 += P.b[12] * u[q][3][0]; s1 += P.b[13] * u[q][3][1]; s2 += P.b[14] * u[q][3][2]; s3 += P.b[15] * u[q][3][3];
        bu[q] = (s0 + s1) + (s2 + s3);
    }
}
__device__ __forceinline__ f32x2 s5_adv(const f32x2 are2, const f32x2 aim2, const f32x2 h, const f32x2 b) { return are2 * h + (aim2 * (f32x2){h.y, h.x} + b); }
__device__ __forceinline__ void s5_pass1(const Frame& F0, int e) {
    const Frame F = refresh(F0);
    LAS float* ub = (LAS float*)(F.lds + F.wave * 4096);
    float* SST = (float*)(F.ws + WS_SST);
    for (int unit = F.gw; unit < 96 * 64; unit += F.NGW) {
        const int sp = unit >> 6, g = unit & 63;
        s5_stage_u(F, sp, g, ub);
#pragma unroll
        for (int dir = 0; dir < 2; ++dir) {
            S5Par P; f32x2 a64; s5_load_par(F, e, dir, g, P, a64);
            const f32x2 are2 = {P.a.x, P.a.x}, aim2 = {-P.a.y, P.a.y};
            f32x2 h = {0.f, 0.f};
#pragma unroll 1
            for (int ch = 0; ch < 16; ++ch) {
                f32x2 bu[4]; s5_bu4(P, dir == 0 ? ub + ch * 64 : ub + (63 - ch * 4) * 16, dir == 0 ? 16 : -16, bu);
#pragma unroll
                for (int q = 0; q < 4; ++q) h = s5_adv(are2, aim2, h, bu[q]); }
            float* o = SST + ((size_t)(sp * 64 + g) * 2 + dir) * 128;
            o[F.lane] = h.x; o[64 + F.lane] = h.y;
        }
        LDS_WAIT();
    }
}
__device__ __forceinline__ float gelu_tanh(float y) { const float x = 0.7978845608028654f * (y + 0.044715f * y * y * y); const float t = 1.0f - 2.0f * __builtin_amdgcn_rcpf(1.0f + __expf(2.0f * x)); return 0.5f * y * (1.0f + t); }
__device__ __forceinline__ void s5_pass2(const Frame& F0, int e) {
    const Frame F = refresh(F0);
    LAS float* ub = (LAS float*)(F.lds + F.wave * 4096);
    LAS unsigned char* hb = F.lds + 32768 + F.wave * 8704;
    const float* SST = (const float*)(F.ws + WS_SST);
    bf16_t* Zb = (bf16_t*)(F.ws + WS_Z);
    for (int unit = F.gw; unit < 96 * 64; unit += F.NGW) {
        int lane_ = F.lane; asm volatile("" : "+v"(lane_));
        const int lane = lane_, fr = lane & 15, fq = lane >> 4;
        const int sp = unit >> 6, g = unit & 63;
        const bool isctx = sp < 64; const int seq_sp0 = isctx ? (sp & ~3) : 64 + ((sp - 64) & ~15), seq_nsp = isctx ? 4 : 16;
        const int nseq = isctx ? (sp >> 2) : ((sp - 64) >> 4);
        s5_stage_u(F, sp, g, ub);
        f32x4 acc[4];
#pragma unroll
        for (int i = 0; i < 4; ++i) acc[i] = (f32x4){0.f, 0.f, 0.f, 0.f};
#pragma unroll
        for (int dir = 0; dir < 2; ++dir) {
            const int nprev = dir == 0 ? sp - seq_sp0 : seq_sp0 + seq_nsp - 1 - sp;
            f32x2 sv[15];
#pragma unroll
            for (int q = 0; q < 15; ++q) { const int qq = q < nprev ? q : 0; const int ss = dir == 0 ? seq_sp0 + qq : seq_sp0 + seq_nsp - 1 - qq;
                const float* sp_ = SST + ((size_t)(ss * 64 + g) * 2 + dir) * 128; sv[q] = (f32x2){sp_[lane], sp_[64 + lane]}; }
            const size_t si = (size_t)((((nseq & 1) * 2 + e) * 2 + dir) * 64 + g) * 64 + lane;
            f32x2 h = {F.in[I_S5RE][si], F.in[I_S5IM][si]};
            const size_t gi = (size_t)((e * 2 + dir) * 64 + g);
            const float* cr = F.in[I_CRE] + (gi * 16 + fr) * 64 + 4 * fq; const float* ci = F.in[I_CIM] + (gi * 16 + fr) * 64 + 4 * fq;
            bf16x8 cf[4];
#pragma unroll
            for (int ks = 0; ks < 4; ++ks) { const f32x4 crv = *(const f32x4*)(cr + 16 * ks), civ = *(const f32x4*)(ci + 16 * ks);
                u32x4 w; w.x = pk2(crv[0], -civ[0]); w.y = pk2(crv[1], -civ[1]); w.z = pk2(crv[2], -civ[2]); w.w = pk2(crv[3], -civ[3]); cf[ks] = __builtin_bit_cast(bf16x8, w); }
            S5Par P; f32x2 a64; s5_load_par(F, e, dir, g, P, a64);
            if (isctx) h = (f32x2){0.f, 0.f};
            { const f32x2 r2 = {a64.x, a64.x}, i2 = {-a64.y, a64.y};
#pragma unroll
              for (int q = 0; q < 15; ++q) { const f32x2 hn = s5_adv(r2, i2, h, sv[q]); h = q < nprev ? hn : h; } }
            const f32x2 are2 = {P.a.x, P.a.x}, aim2 = {-P.a.y, P.a.y};
#pragma unroll
            for (int sbi = 0; sbi < 2; ++sbi) {
                const int sb = dir == 0 ? sbi : 1 - sbi;
#pragma unroll 1
                for (int ch = 0; ch < 8; ++ch) {
                    const int t0 = dir == 0 ? ch * 4 : 31 - ch * 4;
                    f32x2 bu[4]; s5_bu4(P, ub + (sb * 32 + t0) * 16, dir == 0 ? 16 : -16, bu);
#pragma unroll
                    for (int q = 0; q < 4; ++q) { const int t = dir == 0 ? t0 + q : t0 - q;
                        h = s5_adv(are2, aim2, h, bu[q]);
                        *(LAS unsigned*)(hb + t * 272 + lane * 4) = pk2(h.x, h.y); } }
                LDS_WAIT();
#pragma unroll
                for (int mt = 0; mt < 2; ++mt)
#pragma unroll
                    for (int ks = 0; ks < 4; ++ks) { const bf16x8 af = *(const LAS bf16x8*)(hb + (mt * 16 + fr) * 272 + (8 * fq + 32 * ks) * 2);
                        acc[sb * 2 + mt] = __builtin_amdgcn_mfma_f32_16x16x32_bf16(af, cf[ks], acc[sb * 2 + mt], 0, 0, 0); }
                LDS_WAIT();
            }
            if (isctx && ((dir == 0 && sp == seq_sp0 + 3) || (dir == 1 && sp == seq_sp0))) {
                const size_t oi = (size_t)(((nseq * 2 + e) * 2 + dir) * 64 + g) * 64 + lane;
                F.out[OUT_S5RE + oi] = DBG_SCALE * h.x; F.out[OUT_S5IM + oi] = DBG_SCALE * h.y; }
        }
        const float dsk = F.in[I_S5D][e * 1024 + g * 16 + fr];
#pragma unroll
        for (int tile = 0; tile < 4; ++tile)
#pragma unroll
            for (int r = 0; r < 4; ++r) { const int t = 16 * tile + 4 * fq + r; const float y = acc[tile][r] + dsk * ub[t * 16 + fr];
                *(LAS bf16_t*)(hb + t * 32 + fr * 2) = (bf16_t)f2bf(gelu_tanh(y)); }
        LDS_WAIT();
        { const u32x4 z0 = *(const LAS u32x4*)(hb + lane * 32), z1 = *(const LAS u32x4*)(hb + lane * 32 + 16);
          bf16_t* zp = Zb + (size_t)(sp * 64 + lane) * 1024 + g * 16; st16_wt(zp, z0); st16_wt(zp + 8, z1); }
        LDS_WAIT();
    }
}

constexpr int KS_PITCH = 272, VT_PITCH = 264;
constexpr int ENG_KS = 0, ENG_VT = 128 * KS_PITCH;

__device__ __forceinline__ void stage_k_bf16(LAS unsigned char* Ks, const bf16_t* src, int ld, int tid) {
    const int key = tid >> 2, part = tid & 3;
    const u32x4* s = (const u32x4*)(src + (size_t)key * ld + part * 32);
    const u32x4 a = s[0], b = s[1], c = s[2], d = s[3];
    LAS u32x4* dst = (LAS u32x4*)(Ks + key * KS_PITCH + part * 64);
    dst[0] = a; dst[1] = b; dst[2] = c; dst[3] = d;
}
__device__ __forceinline__ void stage_k_f32(LAS unsigned char* Ks, const float* src, int ld, int tid) {
    const int key = tid >> 2, part = tid & 3;
    const f32x4* s = (const f32x4*)(src + (size_t)key * ld + part * 32);
    LAS u32x4* dst = (LAS u32x4*)(Ks + key * KS_PITCH + part * 64);
#pragma unroll
    for (int q = 0; q < 4; ++q) { const f32x4 a = s[2 * q], b = s[2 * q + 1]; u32x4 w; w.x = pk2(a[0], a[1]); w.y = pk2(a[2], a[3]); w.z = pk2(b[0], b[1]); w.w = pk2(b[2], b[3]); dst[q] = w; }
}
__device__ __forceinline__ void unpack8(const u32x4 w, float* x) { x[0] = bflo(w.x); x[1] = bfhi(w.x); x[2] = bflo(w.y); x[3] = bfhi(w.y); x[4] = bflo(w.z); x[5] = bfhi(w.z); x[6] = bflo(w.w); x[7] = bfhi(w.w); }
__device__ __forceinline__ u32x4 pack8(const float* x) { u32x4 w; w.x = pk2(x[0], x[1]); w.y = pk2(x[2], x[3]); w.z = pk2(x[4], x[5]); w.w = pk2(x[6], x[7]); return w; }
__device__ __forceinline__ void stage_k_rope(LAS unsigned char* Ks, const bf16_t* src, int ld, int t0, const float* rope, int tid) {
    const int key = tid >> 2, part = tid & 3, half = part >> 1, sub = part & 1, t = t0 + key, pos = half ? (t & 63) : (t >> 6);
    const bf16_t* p1 = src + (size_t)key * ld + 64 * half + 16 * sub;
    const u32x4 a0 = *(const u32x4*)p1, a1 = *(const u32x4*)(p1 + 8), b0 = *(const u32x4*)(p1 + 32), b1 = *(const u32x4*)(p1 + 40);
    float x1[16], x2[16], o1[16], o2[16];
    unpack8(a0, x1); unpack8(a1, x1 + 8); unpack8(b0, x2); unpack8(b1, x2 + 8);
    const float* cs = rope + pos * 32 + 16 * sub; const float* sn = cs + 2048;
#pragma unroll
    for (int q = 0; q < 4; ++q) { const f32x4 c4 = *(const f32x4*)(cs + 4 * q), s4 = *(const f32x4*)(sn + 4 * q);
#pragma unroll
        for (int j = 0; j < 4; ++j) { const int i = 4 * q + j; o1[i] = x1[i] * c4[j] - x2[i] * s4[j]; o2[i] = x1[i] * s4[j] + x2[i] * c4[j]; } }
    LAS u32x4* d1 = (LAS u32x4*)(Ks + key * KS_PITCH + (64 * half + 16 * sub) * 2);
    d1[0] = pack8(o1); d1[1] = pack8(o1 + 8); d1[4] = pack8(o2); d1[5] = pack8(o2 + 8);
}
template <bool WEIGHTED>
__device__ __forceinline__ void stage_vt_bf16(LAS unsigned char* Vt, const bf16_t* src, int ld, int tid, float wgt) {
    const int key = tid >> 2, part = tid & 3;
    const u32x4* s = (const u32x4*)(src + (size_t)key * ld + part * 32);
    const u32x4 a = s[0], b = s[1], c = s[2], d = s[3];
    const unsigned w[16] = {a.x, a.y, a.z, a.w, b.x, b.y, b.z, b.w, c.x, c.y, c.z, c.w, d.x, d.y, d.z, d.w};
    LAS unsigned char* dst = Vt + (part * 32) * VT_PITCH + key * 2;
#pragma unroll
    for (int q = 0; q < 16; ++q) {
        if (WEIGHTED) { *(LAS bf16_t*)(dst + (2 * q) * VT_PITCH) = (bf16_t)f2bf(bflo(w[q]) * wgt); *(LAS bf16_t*)(dst + (2 * q + 1) * VT_PITCH) = (bf16_t)f2bf(bfhi(w[q]) * wgt); }
        else { *(LAS bf16_t*)(dst + (2 * q) * VT_PITCH) = (bf16_t)(w[q] & 0xffffu); *(LAS bf16_t*)(dst + (2 * q + 1) * VT_PITCH) = (bf16_t)(w[q] >> 16); } }
}
__device__ __forceinline__ void stage_vt_f32(LAS unsigned char* Vt, const float* src, int ld, int tid) {
    const int key = tid >> 2, part = tid & 3;
    const f32x4* s = (const f32x4*)(src + (size_t)key * ld + part * 32);
    LAS unsigned char* dst = Vt + (part * 32) * VT_PITCH + key * 2;
#pragma unroll
    for (int q = 0; q < 8; ++q) { const f32x4 a = s[q];
#pragma unroll
        for (int j = 0; j < 4; ++j) *(LAS bf16_t*)(dst + (4 * q + j) * VT_PITCH) = (bf16_t)f2bf(a[j]); }
}
__device__ __forceinline__ void qk_tiles(const LAS unsigned char* Ks, int sb, int fr, int fq, const bf16x8 (&qf)[4], f32x4 (&st)[2]) {
#pragma unroll
    for (int tt = 0; tt < 2; ++tt) { st[tt] = (f32x4){0.f, 0.f, 0.f, 0.f};
#pragma unroll
        for (int ks = 0; ks < 4; ++ks) { const bf16x8 kf = *(const LAS bf16x8*)(Ks + (32 * sb + 16 * tt + fr) * KS_PITCH + (8 * fq + 32 * ks) * 2);
            st[tt] = __builtin_amdgcn_mfma_f32_16x16x32_bf16(kf, qf[ks], st[tt], 0, 0, 0); } }
}
__device__ __forceinline__ void pv_step(const LAS unsigned char* Vt, int sb, int fr, int fq, const bf16x8 pf, f32x4 (&o)[8]) {
#pragma unroll
    for (int dt = 0; dt < 8; ++dt) { const LAS unsigned char* vp = Vt + (16 * dt + fr) * VT_PITCH + (32 * sb + 4 * fq) * 2;
        const u32x2 lo = *(const LAS u32x2*)vp, hi = *(const LAS u32x2*)(vp + 32);
        u32x4 w; w.x = lo.x; w.y = lo.y; w.z = hi.x; w.w = hi.y;
        o[dt] = __builtin_amdgcn_mfma_f32_16x16x32_bf16(__builtin_bit_cast(bf16x8, w), pf, o[dt], 0, 0, 0); }
}
__device__ __forceinline__ bf16x8 pack_p(const f32x4 p0, const f32x4 p1) { u32x4 w; w.x = pk2(p0[0], p0[1]); w.y = pk2(p0[2], p0[3]); w.z = pk2(p1[0], p1[1]); w.w = pk2(p1[2], p1[3]); return __builtin_bit_cast(bf16x8, w); }
__device__ __forceinline__ void load_q(const bf16_t* qrow, int fq, bf16x8 (&qf)[4]) {
#pragma unroll
    for (int ks = 0; ks < 4; ++ks) qf[ks] = __builtin_bit_cast(bf16x8, *(const u32x4*)(qrow + 8 * fq + 32 * ks));
}
__device__ __forceinline__ void rope_q(bf16x8 (&qf)[4], int t, int fq, const float* rope) {
#pragma unroll
    for (int half = 0; half < 2; ++half) { const int pos = half ? (t & 63) : (t >> 6);
        float x1[8], x2[8], o1[8], o2[8]; unpack8(__builtin_bit_cast(u32x4, qf[2 * half]), x1); unpack8(__builtin_bit_cast(u32x4, qf[2 * half + 1]), x2);
        const float* cs = rope + pos * 32 + 8 * fq; const float* sn = cs + 2048;
        const f32x4 c0 = *(const f32x4*)cs, c1 = *(const f32x4*)(cs + 4), s0 = *(const f32x4*)sn, s1 = *(const f32x4*)(sn + 4);
#pragma unroll
        for (int j = 0; j < 4; ++j) { o1[j] = x1[j] * c0[j] - x2[j] * s0[j]; o2[j] = x1[j] * s0[j] + x2[j] * c0[j]; o1[4 + j] = x1[4 + j] * c1[j] - x2[4 + j] * s1[j]; o2[4 + j] = x1[4 + j] * s1[j] + x2[4 + j] * c1[j]; }
        qf[2 * half] = __builtin_bit_cast(bf16x8, pack8(o1)); qf[2 * half + 1] = __builtin_bit_cast(bf16x8, pack8(o2)); }
}

struct ChunkRegs { u32x4 k[4], v[4]; };
__device__ __forceinline__ void chunk_load(ChunkRegs& R, const bf16_t* ksrc, const bf16_t* vsrc, int ld, int tid) {
    const int key = tid >> 2, part = tid & 3;
    const GAS u32x4* ks = (const GAS u32x4*)((const GAS bf16_t*)ksrc + (size_t)key * ld + part * 32); const GAS u32x4* vs = (const GAS u32x4*)((const GAS bf16_t*)vsrc + (size_t)key * ld + part * 32);
#pragma unroll
    for (int q = 0; q < 4; ++q) { R.k[q] = ks[q]; R.v[q] = vs[q]; }
}
__device__ __forceinline__ void chunk_write(const ChunkRegs& R, LAS unsigned char* Ks, LAS unsigned char* Vt, int tid) {
    const int key = tid >> 2, part = tid & 3;
    LAS u32x4* kd = (LAS u32x4*)(Ks + key * KS_PITCH + part * 64);
#pragma unroll
    for (int q = 0; q < 4; ++q) kd[q] = R.k[q];
    const unsigned w[16] = {R.v[0].x, R.v[0].y, R.v[0].z, R.v[0].w, R.v[1].x, R.v[1].y, R.v[1].z, R.v[1].w, R.v[2].x, R.v[2].y, R.v[2].z, R.v[2].w, R.v[3].x, R.v[3].y, R.v[3].z, R.v[3].w};
    LAS unsigned char* dst = Vt + (part * 32) * VT_PITCH + key * 2;
#pragma unroll
    for (int q = 0; q < 16; ++q) { *(LAS bf16_t*)(dst + (2 * q) * VT_PITCH) = (bf16_t)(w[q] & 0xffffu); *(LAS bf16_t*)(dst + (2 * q + 1) * VT_PITCH) = (bf16_t)(w[q] >> 16); }
}
__device__ __forceinline__ float log_sigmoid_big(float x) { const float y = __expf(-x); return -(y * (1.0f + y * (-0.5f + y * (0.33333334f + y * (-0.25f + y * 0.2f))))); }
__device__ __forceinline__ void ret_unit(const Frame& F, int e, bool isctx, int n, int h, int qb) {
    LAS unsigned char* Ks = F.lds + ENG_KS; LAS unsigned char* Vt = F.lds + ENG_VT;
    const bf16_t* PROJ = (const bf16_t*)(F.ws + WS_PROJ);
    const int lane = F.lane, fr = lane & 15, fq = lane >> 4;
    const int R0 = isctx ? 256 * n : NCTX + 1024 * n, L = isctx ? 256 : 1024, nkc = L >> 7;
    const int iq = 128 * qb + 16 * F.wave + fr;
    const float lgf = log_sigmoid_big(F.in[I_DECAY][(e * 2 + 0) * 8 + h]), lgb = log_sigmoid_big(F.in[I_DECAY][(e * 2 + 1) * 8 + h]);
    const float kscale = 0.08838834764831845f;
    bf16x8 qf[4]; load_q(PROJ + (size_t)(R0 + iq) * EVEN_IN + 1024 + 128 * h, fq, qf);
    f32x4 o[8];
#pragma unroll
    for (int dt = 0; dt < 8; ++dt) o[dt] = (f32x4){0.f, 0.f, 0.f, 0.f};
    ChunkRegs CR; chunk_load(CR, PROJ + (size_t)R0 * EVEN_IN + 2048 + 128 * h, PROJ + (size_t)R0 * EVEN_IN + 3072 + 128 * h, EVEN_IN, F.tid);
    for (int kc = 0; kc < nkc; ++kc) {
        __syncthreads();
        chunk_write(CR, Ks, Vt, F.tid);
        __syncthreads();
        if (kc + 1 < nkc) chunk_load(CR, PROJ + (size_t)(R0 + 128 * (kc + 1)) * EVEN_IN + 2048 + 128 * h, PROJ + (size_t)(R0 + 128 * (kc + 1)) * EVEN_IN + 3072 + 128 * h, EVEN_IN, F.tid);
#pragma unroll 1
        for (int sb = 0; sb < 4; ++sb) {
            f32x4 st[2]; qk_tiles(Ks, sb, fr, fq, qf, st);
#pragma unroll
            for (int tt = 0; tt < 2; ++tt)
#pragma unroll
                for (int r = 0; r < 4; ++r) { const int j = 128 * kc + 32 * sb + 16 * tt + 4 * fq + r; const int df = iq - j;
                    const float m = df > 0 ? __expf((float)df * lgf) : (df < 0 ? __expf((float)(-df) * lgb) : 2.0f);
                    st[tt][r] *= kscale * m; }
            pv_step(Vt, sb, fr, fq, pack_p(st[0], st[1]), o);
        }
    }
    if (!isctx) {
        const bf16_t* qrow = PROJ + (size_t)(R0 + iq) * EVEN_IN + 1024 + 128 * h;
#pragma unroll 1
        for (int dir = 0; dir < 2; ++dir) {
            __syncthreads();
            stage_vt_f32(Vt, F.in[I_SRET] + (size_t)(((n * 2 + e) * 2 + dir) * 8 + h) * 16384, 128, F.tid);
            __syncthreads();
            const float wq = dir == 0 ? __expf((float)(iq + 1) * lgf) : __expf((float)(L - iq) * lgb);
#pragma unroll 1
            for (int sb = 0; sb < 4; ++sb) {
                const u32x2 lo = *(const u32x2*)(qrow + 32 * sb + 4 * fq), hi = *(const u32x2*)(qrow + 32 * sb + 16 + 4 * fq);
                f32x4 p0 = {bflo(lo.x) * wq, bfhi(lo.x) * wq, bflo(lo.y) * wq, bfhi(lo.y) * wq}, p1 = {bflo(hi.x) * wq, bfhi(hi.x) * wq, bflo(hi.y) * wq, bfhi(hi.y) * wq};
                pv_step(Vt, sb, fr, fq, pack_p(p0, p1), o);
            }
        }
    }
    float s = 0.f;
#pragma unroll
    for (int dt = 0; dt < 8; ++dt) s += (o[dt][0] + o[dt][1]) + (o[dt][2] + o[dt][3]);
    s += __shfl_xor(s, 16); s += __shfl_xor(s, 32);
    const float mu = s * (1.0f / 128.0f); float v = 0.f;
#pragma unroll
    for (int dt = 0; dt < 8; ++dt) { const f32x4 d = o[dt] - mu; v += (d[0] * d[0] + d[1] * d[1]) + (d[2] * d[2] + d[3] * d[3]); }
    v += __shfl_xor(v, 16); v += __shfl_xor(v, 32);
    const float rs = rsqrtf(v * (1.0f / 128.0f) + EPS);
    const bf16_t* grow = PROJ + (size_t)(R0 + iq) * EVEN_IN + 4096 + 128 * h; bf16_t* yrow = (bf16_t*)(F.ws + WS_YCAT) + (size_t)(R0 + iq) * 2048 + 1024 + 128 * h;
    const float* gn = F.in[I_GNG] + e * 1024 + 128 * h;
#pragma unroll
    for (int dt = 0; dt < 8; ++dt) { const int ee = 16 * dt + 4 * fq; const u32x2 gw = *(const u32x2*)(grow + ee); const f32x4 g4 = *(const f32x4*)(gn + ee);
        const float g0 = bflo(gw.x), g1 = bfhi(gw.x), g2 = bflo(gw.y), g3 = bfhi(gw.y);
        u32x2 w; w.x = pk2(siluf_(g0) * ((o[dt][0] - mu) * rs * g4[0]), siluf_(g1) * ((o[dt][1] - mu) * rs * g4[1]));
        w.y = pk2(siluf_(g2) * ((o[dt][2] - mu) * rs * g4[2]), siluf_(g3) * ((o[dt][3] - mu) * rs * g4[3]));
        st8_wt(yrow + ee, w); }
}
__device__ __forceinline__ void ret_final_unit(const Frame& F, int e, int n, int h, int dir) {
    LAS unsigned char* Kt = F.lds + ENG_KS; LAS unsigned char* Vt = F.lds + ENG_VT;
    const bf16_t* PROJ = (const bf16_t*)(F.ws + WS_PROJ);
    const int lane = F.lane, fr = lane & 15, fq = lane >> 4, R0 = 256 * n;
    const float lg = log_sigmoid_big(F.in[I_DECAY][(e * 2 + dir) * 8 + h]);
    f32x4 acc[8];
#pragma unroll
    for (int et = 0; et < 8; ++et) acc[et] = (f32x4){0.f, 0.f, 0.f, 0.f};
    for (int kc = 0; kc < 2; ++kc) {
        __syncthreads();
        { const int j = 128 * kc + (F.tid >> 2); const float wj = 0.08838834764831845f * (dir == 0 ? __expf((float)(255 - j) * lg) : __expf((float)j * lg));
          stage_vt_bf16<true>(Kt, PROJ + (size_t)(R0 + 128 * kc) * EVEN_IN + 2048 + 128 * h, EVEN_IN, F.tid, wj); }
        stage_vt_bf16<false>(Vt, PROJ + (size_t)(R0 + 128 * kc) * EVEN_IN + 3072 + 128 * h, EVEN_IN, F.tid, 1.0f);
        __syncthreads();
#pragma unroll
        for (int ks = 0; ks < 4; ++ks) {
            const LAS unsigned char* kp = Kt + (16 * F.wave + fr) * VT_PITCH + (32 * ks + 8 * fq) * 2;
            const u32x2 k0 = *(const LAS u32x2*)kp, k1 = *(const LAS u32x2*)(kp + 8); u32x4 kw; kw.x = k0.x; kw.y = k0.y; kw.z = k1.x; kw.w = k1.y;
#pragma unroll
            for (int et = 0; et < 8; ++et) { const LAS unsigned char* vp = Vt + (16 * et + fr) * VT_PITCH + (32 * ks + 8 * fq) * 2;
                const u32x2 v0 = *(const LAS u32x2*)vp, v1 = *(const LAS u32x2*)(vp + 8); u32x4 vw; vw.x = v0.x; vw.y = v0.y; vw.z = v1.x; vw.w = v1.y;
                acc[et] = __builtin_amdgcn_mfma_f32_16x16x32_bf16(__builtin_bit_cast(bf16x8, kw), __builtin_bit_cast(bf16x8, vw), acc[et], 0, 0, 0); }
        }
    }
    float* outp = F.out + OUT_RET + (size_t)(((n * 2 + e) * 2 + dir) * 8 + h) * 16384;
#pragma unroll
    for (int et = 0; et < 8; ++et)
#pragma unroll
        for (int r = 0; r < 4; ++r) outp[(size_t)(16 * F.wave + 4 * fq + r) * 128 + 16 * et + fr] = DBG_SCALE * acc[et][r];
}
__device__ __forceinline__ void retention_phase(const Frame& F0, int e) {
    const Frame F = refresh(F0);
    const int b = blockIdx.x;
    { int first, cnt, step; if (F.G == 256) { first = b < 128 ? b : 128 + 2 * (b - 128); cnt = b < 128 ? 1 : 2; step = 1; } else { first = b; cnt = (384 - b + F.G - 1) / F.G; step = F.G; }
#pragma unroll 1
      for (int k = 0; k < cnt; ++k) { const int u = first + k * step; const bool isctx = u >= 128; const int c = u - 128;
          ret_unit(F, e, isctx, isctx ? c >> 4 : u >> 6, isctx ? (c >> 1) & 7 : (u >> 3) & 7, isctx ? c & 1 : u & 7); } }
    for (int u = b; u < 256; u += F.G) ret_final_unit(F, e, u >> 4, (u >> 1) & 7, u & 1);
    __syncthreads();
}

template <bool MASKED>
__device__ __forceinline__ void softmax_block(f32x4 (&st)[2], int iq, int j0  , int fq, float& m, float& l, f32x4 (&o)[8]) {
    const float scale = 0.08838834764831845f;
    float mx = -3.0e38f;
#pragma unroll
    for (int tt = 0; tt < 2; ++tt)
#pragma unroll
        for (int r = 0; r < 4; ++r) { float sv = st[tt][r] * scale;
            if (MASKED) { const int j = j0 + 16 * tt + 4 * fq + r; const int df = j - iq; if (df > 128 || df < -128) sv = -3.0e38f; }
            st[tt][r] = sv; mx = fmaxf(mx, sv); }
    mx = fmaxf(mx, __shfl_xor(mx, 16)); mx = fmaxf(mx, __shfl_xor(mx, 32));
    const float mn = fmaxf(m, mx), alpha = __expf(m - mn);
    float ps = 0.f;
#pragma unroll
    for (int tt = 0; tt < 2; ++tt)
#pragma unroll
        for (int r = 0; r < 4; ++r) { const float p = st[tt][r] > -1.0e38f ? __expf(st[tt][r] - mn) : 0.f; st[tt][r] = p; ps += p; }
    l = l * alpha + ps; m = mn;
#pragma unroll
    for (int dt = 0; dt < 8; ++dt) o[dt] *= alpha;
}
__device__ __forceinline__ void attn_unit(const Frame& F, int oi, bool isctx, int n, int hq, int qb) {
    LAS unsigned char* Ks = F.lds + ENG_KS; LAS unsigned char* Vt = F.lds + ENG_VT;
    const bf16_t* PROJ = (const bf16_t*)(F.ws + WS_PROJ); const float* rope = (const float*)(F.ws + WS_ROPE);
    const int lane = F.lane, fr = lane & 15, fq = lane >> 4, hkv = hq >> 2;
    const int R0 = isctx ? 256 * n : NCTX + 1024 * n;
    const int iq = 128 * qb + 16 * F.wave + fr, iq0 = 128 * qb + 16 * F.wave;
    bf16x8 qf[4]; load_q(PROJ + (size_t)(R0 + iq) * ODD_IN + 1024 + 128 * hq, fq, qf);
    if (!isctx) rope_q(qf, iq, fq, rope);
    f32x4 o[8];
#pragma unroll
    for (int dt = 0; dt < 8; ++dt) o[dt] = (f32x4){0.f, 0.f, 0.f, 0.f};
    float m = F.in[I_SINK][oi * 8 + hq], l = fq == 0 ? 1.0f : 0.0f;
    if (isctx) {
        for (int kc = 0; kc < 2; ++kc) {
            __syncthreads();
            stage_k_bf16(Ks, PROJ + (size_t)(R0 + 128 * kc) * ODD_IN + 2048 + 128 * hkv, ODD_IN, F.tid);
            stage_vt_bf16<false>(Vt, PROJ + (size_t)(R0 + 128 * kc) * ODD_IN + 2304 + 128 * hkv, ODD_IN, F.tid, 1.0f);
            __syncthreads();
#pragma unroll 1
            for (int sb = 0; sb < 4; ++sb) { f32x4 st[2]; qk_tiles(Ks, sb, fr, fq, qf, st); softmax_block<false>(st, iq, 0, fq, m, l, o); pv_step(Vt, sb, fr, fq, pack_p(st[0], st[1]), o); }
        }
    } else {
        for (int kc = qb - 1; kc <= qb + 1; ++kc) {
            if (kc < 0 || kc >= 8) continue;
            __syncthreads();
            stage_k_rope(Ks, PROJ + (size_t)(R0 + 128 * kc) * ODD_IN + 2048 + 128 * hkv, ODD_IN, 128 * kc, rope, F.tid);
            stage_vt_bf16<false>(Vt, PROJ + (size_t)(R0 + 128 * kc) * ODD_IN + 2304 + 128 * hkv, ODD_IN, F.tid, 1.0f);
            __syncthreads();
#pragma unroll 1
            for (int sb = 0; sb < 4; ++sb) { const int j0 = 128 * kc + 32 * sb;
                if (j0 > iq0 + 15 + 128 || j0 + 31 < iq0 - 128) continue;
                f32x4 st[2]; qk_tiles(Ks, sb, fr, fq, qf, st); softmax_block<true>(st, iq, j0, fq, m, l, o); pv_step(Vt, sb, fr, fq, pack_p(st[0], st[1]), o); }
        }
        for (int kc = 0; kc < 2; ++kc) {
            __syncthreads();
            stage_k_f32(Ks, F.in[I_CK] + ((size_t)((n * 2 + oi) * 256 + 128 * kc) * 2 + hkv) * 128, 256, F.tid);
            stage_vt_f32(Vt, F.in[I_CV] + ((size_t)((n * 2 + oi) * 256 + 128 * kc) * 2 + hkv) * 128, 256, F.tid);
            __syncthreads();
#pragma unroll 1
            for (int sb = 0; sb < 4; ++sb) { f32x4 st[2]; qk_tiles(Ks, sb, fr, fq, qf, st); softmax_block<false>(st, iq, 0, fq, m, l, o); pv_step(Vt, sb, fr, fq, pack_p(st[0], st[1]), o); }
        }
    }
    l += __shfl_xor(l, 16); l += __shfl_xor(l, 32);
    const float inv = __builtin_amdgcn_rcpf(l);
    bf16_t* yrow = (bf16_t*)(F.ws + WS_YCAT) + (size_t)(R0 + iq) * 2048 + 1024 + 128 * hq;
#pragma unroll
    for (int dt = 0; dt < 8; ++dt) { u32x2 w; w.x = pk2(o[dt][0] * inv, o[dt][1] * inv); w.y = pk2(o[dt][2] * inv, o[dt][3] * inv); st8_wt(yrow + 16 * dt + 4 * fq, w); }
}
__device__ __forceinline__ void attention_phase(const Frame& F0, int oi) {
    const Frame F = refresh(F0);
    const int b = blockIdx.x;
    { int first, cnt, step; if (F.G == 256) { first = b < 128 ? b : 128 + 2 * (b - 128); cnt = b < 128 ? 1 : 2; step = 1; } else { first = b; cnt = (384 - b + F.G - 1) / F.G; step = F.G; }
#pragma unroll 1
      for (int k = 0; k < cnt; ++k) { const int u = first + k * step; const bool isctx = u >= 128; const int c = u - 128;
          attn_unit(F, oi, isctx, isctx ? c >> 4 : u >> 6, isctx ? (c >> 1) & 7 : (u >> 3) & 7, isctx ? c & 1 : u & 7); } }
    __syncthreads();
}
__device__ __forceinline__ void pool_phase(const Frame& F0) {
    const Frame F = refresh(F0);
    const bf16_t* PROJ = (const bf16_t*)(F.ws + WS_PROJ); bf16_t* Pb = (bf16_t*)(F.ws + WS_Z);
    const int total = MROWS * 128;
    for (int it = blockIdx.x * 512 + F.tid; it < total; it += F.G * 512) {
        const int row = it >> 7, ch = it & 127, gi = ch >> 5, w = 2 << gi;
        const bool isctx = row < NCTX; const int R0 = isctx ? (row & ~255) : NCTX + ((row - NCTX) & ~1023), L = isctx ? 256 : 1024, t = row - R0;
        int lo = t - (w >> 1), hi = t + (w >> 1) - 1; lo = lo < 0 ? 0 : (lo > L - 1 ? L - 1 : lo); hi = hi < 0 ? 0 : (hi > L - 1 ? L - 1 : hi);
        float s[8] = {0.f, 0.f, 0.f, 0.f, 0.f, 0.f, 0.f, 0.f};
        for (int j = lo; j <= hi; ++j) { float x[8]; unpack8(*(const u32x4*)(PROJ + (size_t)(R0 + j) * ODD_IN + 8 * ch), x);
#pragma unroll
            for (int q = 0; q < 8; ++q) s[q] += x[q]; }
        float x[8]; unpack8(*(const u32x4*)(PROJ + (size_t)row * ODD_IN + 8 * ch), x);
        const float ic = __builtin_amdgcn_rcpf((float)(hi - lo + 1));
#pragma unroll
        for (int q = 0; q < 8; ++q) s[q] = s[q] * ic - x[q];
        st16_wt(Pb + (size_t)row * 1024 + 8 * ch, pack8(s));
    }
}

#ifndef REP_CONV
#define REP_CONV 1
#endif
#ifndef REP_MIX
#define REP_MIX 1
#endif
#ifndef REP_GU
#define REP_GU 1
#endif
#ifndef STOP_L
#define STOP_L 9
#endif
#ifndef STOP_S
#define STOP_S 1
#endif
#define PH_BEGIN int L_ = l; unsigned char* W_ = args.ws; asm volatile("" : "+s"(L_), "+s"(W_)); const int E_ = L_ >> 1; (void)E_;
#define GEMM_RUNX(MB_, Aoff, Boff, M_, N_, K_, lda_, ldb_, apn_, EPI, CID) do { pg8::Gemm g{(const bf16_t*)(W_ + (Aoff)), (const bf16_t*)(W_ + (Boff)), (M_), (N_), (K_), (lda_), (ldb_), (apn_)}; \
    pg8::StaticOrder S; S.init((M_), (N_), (int)gridDim.x, (CID), 64 * (MB_)); pg8::gemm_phase<MB_>((LAS unsigned char*)lds_raw, g, S, EPI, F.wave); } while (0)
#define GEMM_RUNM(MB_, Aoff, Boff, N_, K_, lda_, ldb_, apn_, EPI) GEMM_RUNX(MB_, Aoff, Boff, MROWS, N_, K_, lda_, ldb_, apn_, EPI, (int)blockIdx.x)
constexpr int GU_R1 = 2304, GU_U1 = (GU_R1 / 256) * (2 * FF / 256);
#define GEMM_GU(S_) do { EpiSwiglu E1{(bf16_t*)(W_ + WS_ACT)}; GEMM_RUNX(4, WS_H, ws_wgu(L_, S_), GU_R1, 2 * FF, D, D, D, 0, E1, (int)blockIdx.x); \
    EpiSwiglu E2{(bf16_t*)(W_ + WS_ACT) + (size_t)GU_R1 * FF}; const int G_ = (int)gridDim.x; \
    GEMM_RUNX(3, WS_H + (size_t)GU_R1 * D * 2, ws_wgu(L_, S_), MROWS - GU_R1, 2 * FF, D, D, D, 0, E2, (int)((blockIdx.x + G_ - GU_U1 % G_) % G_)); } while (0)
#define GEMM_RUN(Aoff, Boff, N_, K_, lda_, ldb_, apn_, EPI) GEMM_RUNM(4, Aoff, Boff, N_, K_, lda_, ldb_, apn_, EPI)
#define MIX_EVEN { PH_BEGIN; s5_pass1(F, E_); retention_phase(F, E_); } xcd_barrier(bar, F.wave); { PH_BEGIN; s5_pass2(F, E_); } xcd_barrier(bar, F.wave);
#define MIX_ODD { PH_BEGIN; pool_phase(F); attention_phase(F, E_); } xcd_barrier(bar, F.wave);
#if REP_MIX == 2
#define MIX_EVEN2 MIX_EVEN
#define MIX_ODD2 MIX_ODD
#else
#define MIX_EVEN2
#define MIX_ODD2
#endif
#define LAYER_BODY(LL_) { constexpr int l = LL_; \
        { PH_BEGIN; GEMM_GU(0); } \
        xcd_barrier(bar, F.wave); \
        { PH_BEGIN; EpiBf16<0> E{(bf16_t*)(W_ + WS_Y), D, nullptr, nullptr, 0}; GEMM_RUNM(3, WS_ACT, ws_wd(L_, 0), D, FF, FF, FF, 0, E); } \
        xcd_barrier(bar, F.wave); \
        { PH_BEGIN; bf16_t* Xb = (bf16_t*)(W_ + WS_X); if (l == 0) norm_phase<false, true>(F, true, L_, 0, 0.5f, true, L_, 1, args.in[I_XP], args.in[I_XS], Xb); else norm_phase<true, true>(F, true, L_, 0, 0.5f, true, L_, 1, Xb, Xb + (size_t)NCTX * D, Xb); } \
        xcd_barrier(bar, F.wave); \
        if (l == STOP_L && STOP_S == 0) goto done; \
        if ((l & 1) == 0) { \
            { PH_BEGIN; EpiBf16<0> E{(bf16_t*)(W_ + WS_PROJ), EVEN_IN, nullptr, nullptr, 0}; GEMM_RUN(WS_H, ws_win(L_), EVEN_IN, D, D, D, 0, E); } \
            xcd_barrier(bar, F.wave); \
            if (l == STOP_L && STOP_S == 1) goto done; \
            MIX_EVEN MIX_EVEN2 \
            if (l == STOP_L && STOP_S == 2) goto done; \
            { PH_BEGIN; EpiMix<0> E{(bf16_t*)(W_ + WS_YCAT), (const bf16_t*)(W_ + WS_Z), args.in[I_GLUB] + E_ * 1024}; GEMM_RUN(WS_Z, ws_wx(L_), 1024, 1024, 1024, 1024, 0, E); } \
            xcd_barrier(bar, F.wave); \
        } else { \
            { PH_BEGIN; EpiBf16<1> E{(bf16_t*)(W_ + WS_PROJ), ODD_IN, args.out + OUT_K, args.out + OUT_V, E_}; GEMM_RUN(WS_H, ws_win(L_), ODD_IN, D, D, D, 0, E); } \
            xcd_barrier(bar, F.wave); \
            if (l == STOP_L && STOP_S == 1) goto done; \
            MIX_ODD MIX_ODD2 \
            if (l == STOP_L && STOP_S == 2) goto done; \
            { PH_BEGIN; EpiMix<1> E{(bf16_t*)(W_ + WS_YCAT), nullptr, args.in[I_POOLS] + E_ * 1024}; GEMM_RUN(WS_Z, ws_wx(L_), 1024, 256, 1024, 256, 256, E); } \
            xcd_barrier(bar, F.wave); \
        } \
        { PH_BEGIN; EpiBf16<0> E{(bf16_t*)(W_ + WS_Y), D, nullptr, nullptr, 0}; GEMM_RUNM(3, WS_YCAT, ws_wout(L_), D, D, D, D, 0, E); } \
        xcd_barrier(bar, F.wave); \
        { PH_BEGIN; bf16_t* Xb = (bf16_t*)(W_ + WS_X); norm_phase<true, true>(F, true, L_, 1, 1.0f, true, L_, 2, Xb, Xb + (size_t)NCTX * D, Xb); } \
        xcd_barrier(bar, F.wave); \
        if (l == STOP_L && STOP_S == 3) goto done; \
        { PH_BEGIN; GEMM_GU(1); } \
        xcd_barrier(bar, F.wave); \
        { PH_BEGIN; EpiBf16<0> E{(bf16_t*)(W_ + WS_Y), D, nullptr, nullptr, 0}; GEMM_RUNM(3, WS_ACT, ws_wd(L_, 1), D, FF, FF, FF, 0, E); } \
        xcd_barrier(bar, F.wave); \
        { PH_BEGIN; bf16_t* Xb = (bf16_t*)(W_ + WS_X); if (l == 3 && STOP_L > 3) norm_phase<true, false>(F, true, L_, 2, 0.5f, false, 0, 0, Xb, Xb + (size_t)NCTX * D, args.out); else norm_phase<true, true>(F, true, L_, 2, 0.5f, true, L_ + 1, 0, Xb, Xb + (size_t)NCTX * D, Xb); } \
        xcd_barrier(bar, F.wave); \
        if (l == STOP_L && STOP_S == 4) goto done; \
    }
__global__ void __launch_bounds__(512, 2) mega_fwd(Args args) {
    extern __shared__ __attribute__((aligned(16))) unsigned char lds_raw[];
    Frame F;
    F.lds = (LAS unsigned char*)lds_raw;
    F.tid = 0; F.lane = 0; F.gw = 0; F.wave = __builtin_amdgcn_readfirstlane(threadIdx.x >> 6);
    F.G = gridDim.x; F.NGW = F.G * NWAVES;
    F.in = args.in; F.out = args.out; F.ws = args.ws;
    for (int u = threadIdx.x; u < (LDS_BYTES - RING_BYTES) / 4; u += 512) ((LAS unsigned*)(F.lds + RING_BYTES))[u] = 0u;
    __syncthreads();
    XcdBarrier bar = xcd_barrier_post((unsigned*)(args.ws + WS_CTL) + 4096, (volatile LAS unsigned*)(F.lds + MISC_OFF) + 8);

    phase_mod(F);
    for (int rep = 0; rep < REP_CONV; ++rep) phase_convert(F);
    xcd_barrier(bar, F.wave);
    norm_phase<false, false>(F, false, 0, 0, 0.f, true, 0, 0, args.in[I_XP], args.in[I_XS], nullptr, false);
    xcd_barrier(bar, F.wave);

    LAYER_BODY(0) LAYER_BODY(1) LAYER_BODY(2) LAYER_BODY(3)
    done:;
    if (false) { const f32x4* Xs = (const f32x4*)(args.ws + WS_X); for (size_t i = (size_t)blockIdx.x * 512 + F.wave * 64 + lane_id(); i < (size_t)MROWS * D / 4; i += (size_t)gridDim.x * 512) ((f32x4*)args.out)[i] = Xs[i]; }
}

extern "C" void kernel_launch(void* const* d_in, const int* in_sizes, int n_in, void* d_out, int out_size, void* d_ws, size_t ws_size, hipStream_t stream) {
    static int grid = 0;
    if (grid == 0) {
        if (n_in != N_IN || (size_t)out_size != OUT_TOTAL || ws_size < WS_END) { fprintf(stderr, "kernel_launch: unexpected sizes n_in %d out %d ws %zu (need %zu)\n", n_in, out_size, ws_size, (size_t)WS_END); grid = -1; return; }
        int dev = 0, cus = 0, per_cu = 0;
        if (hipGetDevice(&dev) != hipSuccess || hipDeviceGetAttribute(&cus, hipDeviceAttributeMultiprocessorCount, dev) != hipSuccess) { grid = -1; return; }
        if (hipFuncSetAttribute((const void*)mega_fwd, hipFuncAttributeMaxDynamicSharedMemorySize, LDS_BYTES) != hipSuccess) { fprintf(stderr, "kernel_launch: hipFuncSetAttribute failed\n"); grid = -1; return; }
        if (hipOccupancyMaxActiveBlocksPerMultiprocessor(&per_cu, (const void*)mega_fwd, 512, LDS_BYTES) != hipSuccess || per_cu < 1) fprintf(stderr, "kernel_launch: occupancy query says %d\n", per_cu);
        (void)hipGetLastError();
        grid = cus;
    }
    if (grid < 0) return;
    (void)hipMemsetAsync((char*)d_ws + WS_CTL, 0, CTL_ZERO_BYTES, stream);
    Args a{};
    for (int i = 0; i < N_IN; ++i) a.in[i] = (const float*)d_in[i];
    a.out = (float*)d_out; a.ws = (unsigned char*)d_ws; a.ph_lo = 0; a.ph_hi = 1 << 30;
    hipLaunchKernelGGL(mega_fwd, dim3(grid), dim3(512), LDS_BYTES, stream, a);
}
```

```cpp
#include <hip/hip_runtime.h>
#include <stdio.h>
#include <stdint.h>

#define LAS __attribute__((address_space(3)))
#define GAS __attribute__((address_space(1)))
typedef unsigned short bf16_t;
typedef short bf16x8 __attribute__((ext_vector_type(8)));
typedef short bf16x4 __attribute__((ext_vector_type(4)));
typedef float f32x4 __attribute__((ext_vector_type(4)));
typedef float f32x2 __attribute__((ext_vector_type(2)));
typedef unsigned u32x4 __attribute__((ext_vector_type(4)));
typedef unsigned u32x2 __attribute__((ext_vector_type(2)));

constexpr int D = 2048, FF = 5632, DEPTH = 4;
constexpr int NCTX = 4096, NDEC = 2048, MROWS = 6144;
constexpr int NMOD = 9;
constexpr int EVEN_IN = 5120, ODD_IN = 2560;
constexpr float EPS = 1e-6f;
#ifndef DBG_SCALE_V
#define DBG_SCALE_V 1.0f
#endif
constexpr float DBG_SCALE = DBG_SCALE_V;

constexpr size_t OUT_Y = 0;
constexpr size_t OUT_S5RE = (size_t)MROWS * D;
constexpr size_t OUT_S5IM = OUT_S5RE + 262144;
constexpr size_t OUT_RET = OUT_S5IM + 262144;
constexpr size_t OUT_K = OUT_RET + 8388608;
constexpr size_t OUT_V = OUT_K + 2097152;
constexpr size_t OUT_TOTAL = OUT_V + 2097152;

enum { I_XP = 0, I_XS, I_C, I_S5RE, I_S5IM, I_SRET, I_CK, I_CV, I_CCTX, I_WMOD, I_BMOD, I_NORMG, I_F1G, I_F1U, I_F1D, I_F2G, I_F2U, I_F2D,
       I_EWIN, I_EWOUT, I_LAMRE, I_LAMIM, I_LOGDT, I_BRE, I_BIM, I_CRE, I_CIM, I_S5D, I_GLUW, I_GLUB, I_DECAY, I_GNG, I_OWIN, I_OWOUT, I_POOLW, I_POOLS, I_SINK, N_IN };

constexpr size_t MiB = 1u << 20;
constexpr size_t WS_CTL = 0, CTL_ZERO_BYTES = 64 * 1024;
constexpr size_t WS_MOD = 1 * MiB;
constexpr size_t WS_ROPE = 2 * MiB;
constexpr size_t SZ_WGU = (size_t)2 * FF * D * 2, SZ_WD = (size_t)D * FF * 2;
constexpr size_t SZ_WIN_E = (size_t)EVEN_IN * D * 2, SZ_WIN_O = (size_t)ODD_IN * D * 2, SZ_WOUT = (size_t)D * D * 2, SZ_WGLU = (size_t)1024 * 1024 * 2, SZ_WPOOL = (size_t)1024 * 256 * 2;
constexpr size_t WS_W = 4 * MiB;
constexpr size_t SZ_LAYER_FFN = 2 * SZ_WGU + 2 * SZ_WD;
constexpr size_t SZ_LAYER = SZ_LAYER_FFN + SZ_WIN_E + SZ_WOUT + SZ_WGLU;
__host__ __device__ constexpr size_t ws_wgu(int l, int s) { return WS_W + (size_t)l * SZ_LAYER + (size_t)s * (SZ_WGU + SZ_WD); }
__host__ __device__ constexpr size_t ws_wd(int l, int s) { return ws_wgu(l, s) + SZ_WGU; }
__host__ __device__ constexpr size_t ws_win(int l) { return WS_W + (size_t)l * SZ_LAYER + SZ_LAYER_FFN; }
__host__ __device__ constexpr size_t ws_wout(int l) { return ws_win(l) + SZ_WIN_E; }
__host__ __device__ constexpr size_t ws_wx(int l) { return ws_wout(l) + SZ_WOUT; }
constexpr size_t WS_WEND = WS_W + 4 * SZ_LAYER;
constexpr size_t al(size_t x) { return (x + MiB - 1) / MiB * MiB; }
constexpr size_t WS_X = al(WS_WEND);
constexpr size_t WS_Y = WS_X + (size_t)MROWS * D * 4;
constexpr size_t WS_H = WS_Y + (size_t)MROWS * D * 4;
constexpr size_t WS_ACT = WS_H + (size_t)MROWS * D * 2;
constexpr size_t WS_PROJ = WS_ACT + (size_t)MROWS * FF * 2;
constexpr size_t WS_Z = WS_PROJ + (size_t)MROWS * EVEN_IN * 2;
constexpr size_t WS_YCAT = WS_Z + (size_t)MROWS * 1024 * 2;
constexpr size_t WS_SST = WS_YCAT + (size_t)MROWS * D * 2;
constexpr size_t WS_END = WS_SST + (size_t)96 * 64 * 2 * 128 * 4;

constexpr int RING_BYTES = 131072;
constexpr int MISC_OFF = RING_BYTES + 320;
constexpr int LDS_BYTES = 147456;
constexpr int NWAVES = 8;

__device__ __forceinline__ unsigned f2bf(float f) { return (unsigned)__builtin_bit_cast(unsigned short, (__bf16)f); }
typedef __bf16 hwbf16x2 __attribute__((ext_vector_type(2)));
__device__ __forceinline__ unsigned pk2(float lo, float hi) { const f32x2 v = {lo, hi}; return __builtin_bit_cast(unsigned, __builtin_convertvector(v, hwbf16x2)); }
__device__ __forceinline__ float bf2f(unsigned short b) { return __builtin_bit_cast(float, ((unsigned)b) << 16); }
__device__ __forceinline__ float bflo(unsigned w) { return __builtin_bit_cast(float, w << 16); }
__device__ __forceinline__ float bfhi(unsigned w) { return __builtin_bit_cast(float, w & 0xffff0000u); }
__device__ __forceinline__ float wave_sum(float v) {
#pragma unroll
    for (int o = 1; o < 64; o <<= 1) v += __shfl_xor(v, o);
    return v;
}
__device__ __forceinline__ float sigmoidf_(float x) { return __builtin_amdgcn_rcpf(1.0f + __expf(-x)); }
__device__ __forceinline__ float siluf_(float x) { return x * __builtin_amdgcn_rcpf(1.0f + __expf(-x)); }
__device__ __forceinline__ int lane_id() { int l; asm volatile("v_mbcnt_lo_u32_b32 %0, -1, 0\n\tv_mbcnt_hi_u32_b32 %0, -1, %0" : "=v"(l)); return l; }
__device__ __forceinline__ void st16_wt(void* p, u32x4 v) { asm volatile("global_store_dwordx4 %0, %1, off sc1\n\ts_nop 1" :: "v"(p), "v"(v) : "memory"); }
__device__ __forceinline__ void st16_wt(void* p, f32x4 v) { asm volatile("global_store_dwordx4 %0, %1, off sc1\n\ts_nop 1" :: "v"(p), "v"(v) : "memory"); }
__device__ __forceinline__ void st8_wt(void* p, u32x2 v) { asm volatile("global_store_dwordx2 %0, %1, off sc1\n\ts_nop 1" :: "v"(p), "v"(v) : "memory"); }
#define LDS_WAIT() asm volatile("s_waitcnt lgkmcnt(0)" ::: "memory")
#define VM_WAIT() asm volatile("s_waitcnt vmcnt(0)" ::: "memory")

namespace pg8 {
#define PG8_LAS __attribute__((address_space(3)))
constexpr int BM = 256, BK = 64, HALF = 128, HTB = HALF * BK * 2, STAGE_BYTES = 8 * HTB, NXCD = 8, WGM = 8;
__host__ __device__ __forceinline__ int lds_byte(int r, int c) { const int st = (r >> 4) * 2 + (c >> 5), rr = r & 15, cc = c & 31, ob = rr * 64 + cc * 2; return st * 1024 + (ob ^ (((ob >> 9) & 1) << 5)); }
__host__ __device__ __forceinline__ void stage_rc(int b, int& R, int& C) { const int st = b / 1024, sb = b % 1024, swz = sb ^ (((sb >> 9) & 1) << 5); R = (st >> 1) * 16 + swz / 64; C = (st & 1) * 32 + (swz % 64) / 2; }
__host__ __device__ __forceinline__ int perm32(int rho) { const int n = rho >> 4, i = rho & 15; return 8 * (i >> 2) + 4 * n + (i & 3); }

struct Unit { int pm, pn; };
struct Gemm { const bf16_t* A; const bf16_t* Bt; int M, N, K, lda, ldb, a_pn_off; };

struct StaticOrder {
    int nM, nN, nwg, G, c;
    __host__ __device__ void init(int M, int N, int G_, int c_, int bm = BM) { nM = M / bm; nN = N / BM; nwg = nM * nN; G = G_; c = c_; }
    __host__ __device__ bool next(int i, Unit& u) const {
        const long L = (long)i * G + c; if (L >= nwg) return false;
        int wgid = (int)L; { const int q = nwg / NXCD, r = nwg % NXCD, xcd = wgid % NXCD, off = wgid / NXCD; wgid = (xcd < r ? xcd * (q + 1) : r * (q + 1) + (xcd - r) * q) + off; }
        const int nig = WGM * nN, gid = wgid / nig, fm = gid * WGM, gsz = (nM - fm) < WGM ? (nM - fm) : WGM;
        u.pm = fm + ((wgid % nig) % gsz); u.pn = (wgid % nig) / gsz; return true;
    }
};

template <int MB, class Epi>
__device__ __forceinline__ void gemm_phase(PG8_LAS unsigned char* lds, const Gemm g, const StaticOrder& S, const Epi& E, int wave_s) {
    int tid_ = wave_s * 64 + lane_id(); asm volatile("" : "+v"(tid_));
    const int tid = tid_, wid = __builtin_amdgcn_readfirstlane(tid >> 6), lane = tid & 63, wr = wid >> 2, wc = wid & 3, fr = lane & 15, fq = lane >> 4;
    const int K = g.K, nt = K / BK;
    unsigned voffA[2], voffB[2];
#pragma unroll
    for (int i = 0; i < 2; ++i) { int R, C; stage_rc(tid * 16 + i * 8192, R, C); const int Rb = (R & ~31) + perm32(R & 31);
        voffA[i] = (unsigned)(R * g.lda + C) * 2u; voffB[i] = (unsigned)(Rb * g.ldb + C) * 2u; }
    const size_t kstep = (size_t)(BK * 2);
    const size_t hstepA = (size_t)(32 * MB) * g.lda * 2, hstepB = (size_t)HALF * g.ldb * 2;
    const size_t tstepA = 2 * hstepA, tstepB = 2 * hstepB;
    const unsigned ldsw = (unsigned)wid * 1024u;
    const int aoff = lds_byte(wr * 16 * MB + fr, fq * 8), boff = lds_byte(wc * 32 + fr, fq * 8);
#define PG8_SA(b, h) (((b) * 2 + (h)) * HTB)
#define PG8_SB(b, h) ((4 + (b) * 2 + (h)) * HTB)
#define PG8_STAGE(bufoff, gbase, voff) do { _Pragma("unroll") for (int _i = 0; _i < 2; ++_i) \
        __builtin_amdgcn_global_load_lds((const unsigned*)((const char*)(gbase) + (voff)[_i]), (PG8_LAS unsigned*)(lds + (bufoff) + ldsw + _i * 8192), 16, 0, 0); } while (0)
#define PG8_LDA(dst, b, h) do { _Pragma("unroll") for (int m = 0; m < MB; ++m) _Pragma("unroll") for (int k = 0; k < 2; ++k) dst[m][k] = *(const PG8_LAS bf16x8*)(lds + PG8_SA(b, h) + aoff + m * 2048 + k * 1024); } while (0)
#define PG8_LDB(dst, b, h) do { _Pragma("unroll") for (int n = 0; n < 2; ++n) _Pragma("unroll") for (int k = 0; k < 2; ++k) dst[n][k] = *(const PG8_LAS bf16x8*)(lds + PG8_SB(b, h) + boff + n * 2048 + k * 1024); } while (0)
#define PG8_MMA(ai, bj, At, Bt) do { __builtin_amdgcn_s_setprio(1); _Pragma("unroll") for (int m = 0; m < MB; ++m) _Pragma("unroll") for (int n = 0; n < 2; ++n) _Pragma("unroll") for (int k = 0; k < 2; ++k) \
        acc[ai][bj][m][n] = __builtin_amdgcn_mfma_f32_16x16x32_bf16(Bt[n][k], At[m][k], acc[ai][bj][m][n], 0, 0, 0); __builtin_amdgcn_s_setprio(0); } while (0)
#define PG8_WAIT_V(n) asm volatile("s_waitcnt vmcnt(" #n ")" ::: "memory")
#define PG8_WAIT_L(n) asm volatile("s_waitcnt lgkmcnt(" #n ")" ::: "memory")
#define PG8_BAR __builtin_amdgcn_s_barrier()
#define PG8_SCHED __builtin_amdgcn_sched_barrier(0)
    Unit cur, nxt; int ui = 0;
    if (!S.next(0, cur)) return;
    f32x4 acc[2][2][MB][2];
#pragma unroll
    for (int a = 0; a < 2; ++a)
#pragma unroll
        for (int b = 0; b < 2; ++b)
#pragma unroll
            for (int m = 0; m < MB; ++m)
#pragma unroll
                for (int n = 0; n < 2; ++n) acc[a][b][m][n] = (f32x4){0.f, 0.f, 0.f, 0.f};
    bf16x8 At[MB][2], B0[2][2], B1[2][2];
    const char* cA = (const char*)g.A + (size_t)cur.pm * tstepA + (size_t)cur.pn * g.a_pn_off * 2; const char* cB = (const char*)g.Bt + (size_t)cur.pn * tstepB;
    PG8_STAGE(PG8_SB(0, 0), cB, voffB); PG8_STAGE(PG8_SB(0, 1), cB + hstepB, voffB); PG8_STAGE(PG8_SA(0, 0), cA, voffA); PG8_STAGE(PG8_SA(0, 1), cA + hstepA, voffA);
    if (wr == 1) PG8_BAR;
    PG8_WAIT_V(2); PG8_BAR;
    PG8_STAGE(PG8_SB(1, 0), cB + kstep, voffB); PG8_STAGE(PG8_SA(1, 0), cA + kstep, voffA); PG8_STAGE(PG8_SB(1, 1), cB + hstepB + kstep, voffB);
    PG8_WAIT_V(6); PG8_BAR;
    for (;;) {
        const bool has_next = S.next(ui + 1, nxt);
        const char* nA = has_next ? (const char*)g.A + (size_t)nxt.pm * tstepA + (size_t)nxt.pn * g.a_pn_off * 2 : cA; const char* nB = has_next ? (const char*)g.Bt + (size_t)nxt.pn * tstepB : cB;
        for (int t = 0; t < nt; t += 2) {
            const bool last = (t == nt - 2);
            const char* a1 = cA + (size_t)(t + 1) * kstep;
            const char* a2 = last ? nA : cA + (size_t)(t + 2) * kstep; const char* b2 = last ? nB : cB + (size_t)(t + 2) * kstep;
            const char* a3 = a2 + kstep; const char* b3 = b2 + kstep;
            PG8_LDB(B0, 0, 0); PG8_LDB(B1, 0, 1); PG8_SCHED; PG8_LDA(At, 0, 0); PG8_STAGE(PG8_SA(1, 1), a1 + hstepA, voffA);
            PG8_WAIT_V(8); PG8_WAIT_L(0); PG8_BAR; PG8_MMA(0, 0, At, B0); PG8_MMA(0, 1, At, B1); PG8_BAR; PG8_SCHED;
            PG8_LDA(At, 0, 1); PG8_STAGE(PG8_SB(0, 0), b2, voffB); PG8_STAGE(PG8_SB(0, 1), b2 + hstepB, voffB); PG8_STAGE(PG8_SA(0, 0), a2, voffA);
            PG8_WAIT_V(8); PG8_WAIT_L(0); PG8_BAR; PG8_MMA(1, 0, At, B0); PG8_MMA(1, 1, At, B1); PG8_BAR; PG8_SCHED;
            PG8_LDB(B0, 1, 0); PG8_LDB(B1, 1, 1); PG8_SCHED; PG8_LDA(At, 1, 0); PG8_STAGE(PG8_SA(0, 1), a2 + hstepA, voffA);
            PG8_WAIT_V(8); PG8_WAIT_L(0); PG8_BAR; PG8_MMA(0, 0, At, B0); PG8_MMA(0, 1, At, B1); PG8_BAR; PG8_SCHED;
            PG8_LDA(At, 1, 1); PG8_STAGE(PG8_SB(1, 0), b3, voffB); PG8_STAGE(PG8_SB(1, 1), b3 + hstepB, voffB); PG8_STAGE(PG8_SA(1, 0), a3, voffA);
            PG8_WAIT_V(8); PG8_WAIT_L(0); PG8_BAR; PG8_MMA(1, 0, At, B0); PG8_MMA(1, 1, At, B1); PG8_BAR; PG8_SCHED;
        }
        if (wr == 0) PG8_BAR;
        E(acc, cur, wr, wc, fr, fq);
        if (!has_next) break;
#pragma unroll
        for (int a = 0; a < 2; ++a)
#pragma unroll
            for (int b = 0; b < 2; ++b)
#pragma unroll
                for (int m = 0; m < MB; ++m)
#pragma unroll
                    for (int n = 0; n < 2; ++n) acc[a][b][m][n] = (f32x4){0.f, 0.f, 0.f, 0.f};
        cur = nxt; cA = nA; cB = nB; ++ui;
        if (wr == 1) PG8_BAR;
    }
    PG8_WAIT_V(0);
    PG8_BAR;
#undef PG8_SA
#undef PG8_SB
#undef PG8_STAGE
#undef PG8_LDA
#undef PG8_LDB
#undef PG8_MMA
#undef PG8_WAIT_V
#undef PG8_WAIT_L
#undef PG8_BAR
#undef PG8_SCHED
}
}

struct EpiF32 {
    float* C; int ldc;
    template <int MB> __device__ __forceinline__ void operator()(const f32x4 (&acc)[2][2][MB][2], const pg8::Unit& u, int wr, int wc, int fr, int fq) const {
        const int row0 = u.pm * (64 * MB) + wr * (16 * MB) + fr, col0 = u.pn * 256 + wc * 32 + 8 * fq;
#pragma unroll
        for (int ai = 0; ai < 2; ++ai)
#pragma unroll
            for (int m = 0; m < MB; ++m) { float* rowp = C + (size_t)(row0 + ai * (32 * MB) + m * 16) * ldc + col0;
#pragma unroll
                for (int bj = 0; bj < 2; ++bj) { *(f32x4*)(rowp + bj * 128) = acc[ai][bj][m][0]; *(f32x4*)(rowp + bj * 128 + 4) = acc[ai][bj][m][1]; } }
    }
};
struct EpiSwiglu {
    bf16_t* O;
    template <int MB> __device__ __forceinline__ void operator()(const f32x4 (&acc)[2][2][MB][2], const pg8::Unit& u, int wr, int wc, int fr, int fq) const {
        const int row0 = u.pm * (64 * MB) + wr * (16 * MB) + fr, col0 = u.pn * 128 + wc * 32 + 8 * fq;
#pragma unroll
        for (int ai = 0; ai < 2; ++ai)
#pragma unroll
            for (int m = 0; m < MB; ++m) { bf16_t* rowp = O + (size_t)(row0 + ai * (32 * MB) + m * 16) * FF + col0;
                const f32x4 g0 = acc[ai][0][m][0], g1 = acc[ai][0][m][1], u0 = acc[ai][1][m][0], u1 = acc[ai][1][m][1];
                u32x4 w; w.x = pk2(siluf_(g0[0]) * u0[0], siluf_(g0[1]) * u0[1]); w.y = pk2(siluf_(g0[2]) * u0[2], siluf_(g0[3]) * u0[3]);
                w.z = pk2(siluf_(g1[0]) * u1[0], siluf_(g1[1]) * u1[1]); w.w = pk2(siluf_(g1[2]) * u1[2], siluf_(g1[3]) * u1[3]);
                st16_wt(rowp, w); }
    }
};
template <int MODE> struct EpiBf16 {
    bf16_t* O; int ldc; float* outk; float* outv; int o;
    template <int MB> __device__ __forceinline__ void operator()(const f32x4 (&acc)[2][2][MB][2], const pg8::Unit& u, int wr, int wc, int fr, int fq) const {
        const int row0 = u.pm * (64 * MB) + wr * (16 * MB) + fr, col0 = u.pn * 256 + wc * 32 + 8 * fq;
#pragma unroll
        for (int ai = 0; ai < 2; ++ai)
#pragma unroll
            for (int m = 0; m < MB; ++m) { const int row = row0 + ai * (32 * MB) + m * 16; bf16_t* rowp = O + (size_t)row * ldc + col0;
#pragma unroll
                for (int bj = 0; bj < 2; ++bj) { const f32x4 v0 = acc[ai][bj][m][0], v1 = acc[ai][bj][m][1];
                    u32x4 w; w.x = pk2(v0[0], v0[1]); w.y = pk2(v0[2], v0[3]); w.z = pk2(v1[0], v1[1]); w.w = pk2(v1[2], v1[3]);
                    st16_wt(rowp + bj * 128, w);
                    if (MODE == 1) { if (u.pn >= 8 && row < NCTX) { float* dst = (u.pn == 8 ? outk : outv) + ((size_t)((row >> 8) * 2 + o) * 256 + (row & 255)) * 256 + (col0 - u.pn * 256) + bj * 128;
                        *(f32x4*)dst = DBG_SCALE * v0; *(f32x4*)(dst + 4) = DBG_SCALE * v1; } } } }
    }
};
template <int MODE> struct EpiMix {
    bf16_t* O; const bf16_t* Zb; const float* vec;
    template <int MB> __device__ __forceinline__ void operator()(const f32x4 (&acc)[2][2][MB][2], const pg8::Unit& u, int wr, int wc, int fr, int fq) const {
        const int row0 = u.pm * (64 * MB) + wr * (16 * MB) + fr, col0 = u.pn * 256 + wc * 32 + 8 * fq;
        f32x4 bv[2][2];
#pragma unroll
        for (int bj = 0; bj < 2; ++bj) { bv[bj][0] = *(const f32x4*)(vec + col0 + bj * 128); bv[bj][1] = *(const f32x4*)(vec + col0 + bj * 128 + 4); }
#pragma unroll
        for (int ai = 0; ai < 2; ++ai)
#pragma unroll
            for (int m = 0; m < MB; ++m) { const int row = row0 + ai * (32 * MB) + m * 16; bf16_t* rowp = O + (size_t)row * 2048 + col0;
#pragma unroll
                for (int bj = 0; bj < 2; ++bj) { f32x4 v0 = acc[ai][bj][m][0], v1 = acc[ai][bj][m][1];
                    if (MODE == 0) { const u32x4 zz = *(const u32x4*)(Zb + (size_t)row * 1024 + col0 + bj * 128);
                        v0 += bv[bj][0]; v1 += bv[bj][1];
                        v0[0] = bflo(zz.x) * sigmoidf_(v0[0]); v0[1] = bfhi(zz.x) * sigmoidf_(v0[1]); v0[2] = bflo(zz.y) * sigmoidf_(v0[2]); v0[3] = bfhi(zz.y) * sigmoidf_(v0[3]);
                        v1[0] = bflo(zz.z) * sigmoidf_(v1[0]); v1[1] = bfhi(zz.z) * sigmoidf_(v1[1]); v1[2] = bflo(zz.w) * sigmoidf_(v1[2]); v1[3] = bfhi(zz.w) * sigmoidf_(v1[3]); }
                    else { v0 *= bv[bj][0]; v1 *= bv[bj][1]; }
                    u32x4 w; w.x = pk2(v0[0], v0[1]); w.y = pk2(v0[2], v0[3]); w.z = pk2(v1[0], v1[1]); w.w = pk2(v1[2], v1[3]);
                    st16_wt(rowp + bj * 128, w); } }
    }
};

#define XB_TMO      128
#define XB_XCNT(j)  (256  + 64 * (j))
#define XB_XSUB(j)  (1280 + 64 * (j))
#define XB_XGEN(j)  (2304 + 64 * (j))
#define XB_TOP      3328
#define XB_TOPGEN   3392
#define XCD_BAR_WORDS 3456
#define XB_SPIN_CAP (1u << 18)
__device__ __forceinline__ unsigned xb_ld(unsigned* p)              { return __hip_atomic_load(p, __ATOMIC_RELAXED, __HIP_MEMORY_SCOPE_AGENT); }
__device__ __forceinline__ unsigned xb_add(unsigned* p, unsigned v) { return __hip_atomic_fetch_add(p, v, __ATOMIC_RELAXED, __HIP_MEMORY_SCOPE_AGENT); }
__device__ __forceinline__ unsigned xb_xcc_id() { return (unsigned)__builtin_amdgcn_s_getreg((3 << 11) | 20) & 0xFu; }
#define XB_SPIN(cond, bar) do { unsigned _sp = 0; while (cond) { __builtin_amdgcn_s_sleep(1); \
    if ((++_sp & 255u) == 0u) { if (xb_ld(&(bar)[XB_TMO])) break; if (_sp > XB_SPIN_CAP) { atomicAdd(&(bar)[XB_TMO], 1u); break; } } } } while (0)
struct XcdBarrier { unsigned* bar; unsigned x; volatile LAS unsigned* st; };
__device__ __forceinline__ XcdBarrier xcd_barrier_post(unsigned* bar, volatile LAS unsigned* st) {
    XcdBarrier b; b.bar = bar; b.x = xb_xcc_id(); b.st = st;
    if (threadIdx.x == 0) (void)xb_add(&bar[XB_XCNT(b.x)], 1u);
    return b;
}
__device__ __forceinline__ void xcd_barrier_complete(unsigned* bar, unsigned x, unsigned& nloc, unsigned& nx) {
    const unsigned G = gridDim.x * gridDim.y * gridDim.z;
    unsigned sum, cnt, mine, sp = 0u;
    for (;;) {
        sum = 0u; cnt = 0u; mine = 0u;
#pragma unroll
        for (unsigned j = 0; j < 16; ++j) { const unsigned c = xb_ld(&bar[XB_XCNT(j)]); sum += c; cnt += (c > 0u) ? 1u : 0u; mine = (j == x) ? c : mine; }
        if (sum == G) break;
        __builtin_amdgcn_s_sleep(1);
        if ((++sp & 255u) == 0u) { if (xb_ld(&bar[XB_TMO])) break; if (sp > XB_SPIN_CAP) { atomicAdd(&bar[XB_TMO], 1u); break; } }
    }
    nloc = mine > 0u ? mine : 1u; nx = cnt > 0u ? cnt : 1u;
}
__device__ __forceinline__ void xcd_barrier(const XcdBarrier& b, int wave_s) {
    asm volatile("s_waitcnt vmcnt(0)" ::: "memory");
    __syncthreads();
    if (wave_s == 0 && lane_id() == 0) {
        unsigned* bar = b.bar; unsigned bx = b.x; asm volatile("" : "+s"(bar), "+s"(bx));
        __builtin_amdgcn_s_waitcnt(0);
        unsigned nloc = b.st[0], nx = b.st[1];
        if (nloc == 0u) { xcd_barrier_complete(bar, bx, nloc, nx); b.st[0] = nloc; b.st[1] = nx; }
        const unsigned old = xb_add(&bar[XB_XSUB(bx)], 1u);
        const unsigned gen = old / nloc;
        if (old + 1u == (gen + 1u) * nloc) {
            __builtin_amdgcn_fence(__ATOMIC_RELEASE, "agent");
            asm volatile("s_waitcnt vmcnt(0)" ::: "memory");
            const unsigned og = xb_add(&bar[XB_TOP], 1u);
            const unsigned tg = og / nx;
            if (og + 1u == (tg + 1u) * nx) xb_add(&bar[XB_TOPGEN], 1u);
            else XB_SPIN(xb_ld(&bar[XB_TOPGEN]) == tg, bar);
            __builtin_amdgcn_fence(__ATOMIC_ACQUIRE, "agent");
            xb_add(&bar[XB_XGEN(bx)], 1u);
            asm volatile("s_waitcnt vmcnt(0)" ::: "memory");
        } else {
            XB_SPIN(xb_ld(&bar[XB_XGEN(bx)]) == gen, bar);
            __builtin_amdgcn_fence(__ATOMIC_ACQUIRE, "agent");
            asm volatile("s_waitcnt vmcnt(0)" ::: "memory");
        }
    }
    __syncthreads();
}

struct Args { const float* in[N_IN]; float* out; unsigned char* ws; int ph_lo, ph_hi; };
struct Frame {
    LAS unsigned char* lds;
    int tid, lane, wave, G, gw, NGW;
    const float* const* in;
    float* out; unsigned char* ws;
};
__device__ __forceinline__ Frame refresh(const Frame& F0) {
    Frame F = F0; int ln = lane_id(); asm volatile("" : "+v"(ln));
    F.lane = ln; F.tid = F0.wave * 64 + ln; F.gw = blockIdx.x * NWAVES + F0.wave;
    return F;
}

struct ConvJob { int in_idx; unsigned src_off; int K, N; unsigned long long dst_off; int ldd; int map; int row_off; };
constexpr int NJOBS = 4 * 6 + 2 * 3 + 2 * 6;
struct ConvTable { ConvJob j[NJOBS]; int cum[NJOBS + 1]; };
constexpr ConvTable make_conv_table() {
    ConvTable t{}; int n = 0;
    for (int l = 0; l < DEPTH; ++l) {
        for (int s = 0; s < 2; ++s) {
            const int ig = s ? I_F2G : I_F1G, iu = s ? I_F2U : I_F1U, id = s ? I_F2D : I_F1D;
            t.j[n++] = ConvJob{ig, (unsigned)((size_t)l * D * FF), D, FF, ws_wgu(l, s), D, 1, 0};
            t.j[n++] = ConvJob{iu, (unsigned)((size_t)l * D * FF), D, FF, ws_wgu(l, s), D, 2, 0};
            t.j[n++] = ConvJob{id, (unsigned)((size_t)l * FF * D), FF, D, ws_wd(l, s), FF, 0, 0};
        }
        const int e = l >> 1;
        if ((l & 1) == 0) {
            t.j[n++] = ConvJob{I_EWIN, (unsigned)((size_t)e * D * EVEN_IN), D, EVEN_IN, ws_win(l), D, 0, 0};
            t.j[n++] = ConvJob{I_EWOUT, (unsigned)((size_t)e * D * D), D, D, ws_wout(l), D, 0, 0};
            t.j[n++] = ConvJob{I_GLUW, (unsigned)((size_t)e * 1024 * 1024), 1024, 1024, ws_wx(l), 1024, 0, 0};
        } else {
            t.j[n++] = ConvJob{I_OWIN, (unsigned)((size_t)e * D * ODD_IN), D, ODD_IN, ws_win(l), D, 0, 0};
            t.j[n++] = ConvJob{I_OWOUT, (unsigned)((size_t)e * D * D), D, D, ws_wout(l), D, 0, 0};
            for (int g = 0; g < 4; ++g) t.j[n++] = ConvJob{I_POOLW, (unsigned)((size_t)(e * 4 + g) * 256 * 256), 256, 256, ws_wx(l), 256, 0, g * 256};
        }
    }
    int c = 0;
    for (int i = 0; i < NJOBS; ++i) { t.cum[i] = c; c += (t.j[i].K / 64) * (t.j[i].N / 64); }
    t.cum[NJOBS] = c;
    return t;
}
__device__ const ConvTable g_conv = make_conv_table();

__device__ __forceinline__ void conv_tile(const float* src, int N, int k0, int n0, bf16_t* dst, int ldd, int drow0, LAS unsigned char* scr, int lane) {
    f32x4 v[16];
    const GAS float* sp = (const GAS float*)src + (size_t)(k0 + 2 * (lane >> 4)) * N + n0 + 4 * (lane & 15);
#pragma unroll
    for (int i = 0; i < 16; ++i) v[i] = *(const GAS f32x4*)(sp + (size_t)((i & 1) + 8 * (i >> 1)) * N);
#pragma unroll
    for (int i = 0; i < 16; i += 2) { const int k = 2 * (lane >> 4) + 8 * (i >> 1);
#pragma unroll
        for (int j = 0; j < 4; ++j) { const int n = 4 * (lane & 15) + j; *(LAS unsigned*)(scr + n * 144 + k * 2) = pk2(v[i][j], v[i + 1][j]); } }
    LDS_WAIT();
#pragma unroll
    for (int i = 0; i < 8; ++i) { const int q = lane + 64 * i, n = q >> 3, c = q & 7;
        const u32x4 w = *(const LAS u32x4*)(scr + n * 144 + c * 16);
        *(GAS u32x4*)((GAS bf16_t*)dst + (size_t)(drow0 + n) * ldd + k0 + 8 * c) = w; }
    LDS_WAIT();
}

__device__ __forceinline__ void phase_convert(const Frame& F0) {
    const Frame F = refresh(F0);
    LAS unsigned char* scr = F.lds + F.wave * 9216;
    const int total = g_conv.cum[NJOBS];
    int j = 0;
    for (int t = F.gw; t < total; t += F.NGW) {
        while (t >= g_conv.cum[j + 1]) ++j;
        const ConvJob jb = g_conv.j[j];
        const int r = t - g_conv.cum[j], nbN = jb.N >> 6, kb = r / nbN, nb = r - kb * nbN, n0 = nb * 64;
        const int drow0 = jb.map == 0 ? jb.row_off + n0 : (256 * (n0 >> 7) + (n0 & 127) + (jb.map == 2 ? 128 : 0));
        conv_tile(F.in[jb.in_idx] + jb.src_off, jb.N, kb * 64, n0, (bf16_t*)(F.ws + jb.dst_off), jb.ldd, drow0, scr, F.lane);
    }
}

__device__ __forceinline__ void phase_mod(const Frame& F0) {
    const Frame F = refresh(F0);
    LAS float* sc = (LAS float*)(F.lds + 73728);
    LAS float* red = (LAS float*)(F.lds + 73728 + 24576);
    const float* cctx = F.in[I_CCTX]; const float* cdec = F.in[I_C];
    for (int idx = F.tid; idx < 3 * D; idx += 512) { const int set = idx >> 11, k = idx & 2047; const float v = set == 0 ? cctx[k] : cdec[(set - 1) * D + k]; sc[idx] = v / (1.0f + __expf(-v)); }
    __syncthreads();
    float* MOD = (float*)(F.ws + WS_MOD);
    for (int item = blockIdx.x; item < 256; item += F.G) {
        const int l = item >> 6, col0 = (item & 63) * 288;
        if (F.tid < 504) {
            const int cg = F.tid % 72, kg = F.tid / 72;
            f32x4 a0 = {0.f, 0.f, 0.f, 0.f}, a1 = a0, a2 = a0;
            const float* W = F.in[I_WMOD] + (size_t)l * D * (NMOD * D) + col0 + cg * 4;
#pragma unroll 8
            for (int k = kg; k < D; k += 7) { const f32x4 w = *(const f32x4*)(W + (size_t)k * (NMOD * D)); a0 += sc[k] * w; a1 += sc[2048 + k] * w; a2 += sc[4096 + k] * w; }
            LAS float* rp = red + (kg * 72 + cg) * 12;
            *(LAS f32x4*)rp = a0; *(LAS f32x4*)(rp + 4) = a1; *(LAS f32x4*)(rp + 8) = a2;
        }
        __syncthreads();
        for (int o = F.tid; o < 864; o += 512) { const int set = o / 288, cc = o % 288, cg = cc >> 2, jj = cc & 3; float s = F.in[I_BMOD][(size_t)l * (NMOD * D) + col0 + cc];
#pragma unroll
            for (int kg = 0; kg < 7; ++kg) s += red[(kg * 72 + cg) * 12 + set * 4 + jj];
            MOD[(size_t)(l * 3 + set) * (NMOD * D) + col0 + cc] = s; }
        __syncthreads();
    }
    if (blockIdx.x == 0) { float* rt = (float*)(F.ws + WS_ROPE);
        for (int idx = F.tid; idx < 2048; idx += 512) { const int pos = idx >> 5, i = idx & 31; const float fr = powf(10000.0f, -(float)i / 32.0f); const float ang = (float)pos * fr;
            rt[idx] = cosf(ang); rt[2048 + idx] = sinf(ang); } }
}

template <bool XIN_BF, bool XOUT_BF>
__device__ __forceinline__ void norm_phase(const Frame& F0, bool has_post, int l_post, int j_post, float wpost, bool has_pre, int l_pre, int j_pre,
                                           const void* xs_ctx, const void* xs_dec, void* xdst, bool store_x = true) {
    const Frame F = refresh(F0);
    const float* MOD = (const float*)(F.ws + WS_MOD); const bf16_t* Yb = (const bf16_t*)(F.ws + WS_Y); bf16_t* Hb = (bf16_t*)(F.ws + WS_H);
    const float* ng = F.in[I_NORMG];
    for (int row = F.gw; row < MROWS; row += F.NGW) {
        const int set = row < NCTX ? 0 : 1 + ((row - NCTX) >> 10);
        f32x4 x[8];
        if (XIN_BF) { const GAS bf16_t* xr = row < NCTX ? (const GAS bf16_t*)xs_ctx + (size_t)row * D : (const GAS bf16_t*)xs_dec + (size_t)(row - NCTX) * D;
#pragma unroll
            for (int j = 0; j < 8; ++j) { const u32x2 xw = *(const GAS u32x2*)(xr + 4 * F.lane + 256 * j); x[j] = (f32x4){bflo(xw.x), bfhi(xw.x), bflo(xw.y), bfhi(xw.y)}; } }
        else { const GAS float* xr = row < NCTX ? (const GAS float*)xs_ctx + (size_t)row * D : (const GAS float*)xs_dec + (size_t)(row - NCTX) * D;
#pragma unroll
            for (int j = 0; j < 8; ++j) x[j] = *(const GAS f32x4*)(xr + 4 * F.lane + 256 * j); }
        if (has_post) {
            f32x4 y[8]; float ss = 0.f;
#pragma unroll
            for (int j = 0; j < 8; ++j) { const u32x2 yw = *(const u32x2*)(Yb + (size_t)row * D + 4 * F.lane + 256 * j); y[j] = (f32x4){bflo(yw.x), bfhi(yw.x), bflo(yw.y), bfhi(yw.y)}; ss += (y[j][0] * y[j][0] + y[j][1] * y[j][1]) + (y[j][2] * y[j][2] + y[j][3] * y[j][3]); }
            const float ry = rsqrtf(wave_sum(ss) * (1.0f / D) + EPS);
            const float* gate = MOD + (size_t)((l_post * 3 + set) * NMOD + 3 * j_post + 2) * D; const float* gp = ng + (size_t)(l_post * 6 + 2 * j_post + 1) * D;
#pragma unroll
            for (int j = 0; j < 8; ++j) { const f32x4 gt = *(const f32x4*)(gate + 4 * F.lane + 256 * j), gg = *(const f32x4*)(gp + 4 * F.lane + 256 * j);
                x[j] += wpost * gt * ((y[j] * ry) * gg); }
        }
        if (store_x) {
            if (XOUT_BF) {
#pragma unroll
                for (int j = 0; j < 8; ++j) { u32x2 w; w.x = pk2(x[j][0], x[j][1]); w.y = pk2(x[j][2], x[j][3]); st8_wt((bf16_t*)xdst + (size_t)row * D + 4 * F.lane + 256 * j, w); }
            } else {
#pragma unroll
                for (int j = 0; j < 8; ++j) st16_wt((float*)xdst + (size_t)row * D + 4 * F.lane + 256 * j, x[j]); } }
        if (has_pre) {
            float ss = 0.f;
#pragma unroll
            for (int j = 0; j < 8; ++j) ss += (x[j][0] * x[j][0] + x[j][1] * x[j][1]) + (x[j][2] * x[j][2] + x[j][3] * x[j][3]);
            const float rx = rsqrtf(wave_sum(ss) * (1.0f / D) + EPS);
            const float* sh = MOD + (size_t)((l_pre * 3 + set) * NMOD + 3 * j_pre) * D; const float* scl = sh + D; const float* gp = ng + (size_t)(l_pre * 6 + 2 * j_pre) * D;
#pragma unroll
            for (int j = 0; j < 8; ++j) { const f32x4 s0 = *(const f32x4*)(sh + 4 * F.lane + 256 * j), s1 = *(const f32x4*)(scl + 4 * F.lane + 256 * j), gg = *(const f32x4*)(gp + 4 * F.lane + 256 * j);
                const f32x4 h = ((x[j] * rx) * gg) * (1.0f + s1) + s0;
                u32x2 w; w.x = pk2(h[0], h[1]); w.y = pk2(h[2], h[3]);
                st8_wt(Hb + (size_t)row * D + 4 * F.lane + 256 * j, w); }
        }
    }
}

struct S5Par { f32x2 a; f32x2 b[16]; };
__device__ __forceinline__ void s5_load_par(const Frame& F, int e, int dir, int g, S5Par& P, f32x2& a64) {
    const int p = F.lane; const size_t gi = (size_t)((e * 2 + dir) * 64 + g);
    float lr = F.in[I_LAMRE][gi * 64 + p]; lr = fminf(lr, -1e-4f); const float li = F.in[I_LAMIM][gi * 64 + p];
    const float dt = __expf(F.in[I_LOGDT][gi]);
    const float mag = __expf(lr * dt); float tt = li * dt * 0.15915494309189535f; tt -= rintf(tt);
    const float are = mag * __builtin_amdgcn_cosf(tt), aim = mag * __builtin_amdgcn_sinf(tt);
    P.a = (f32x2){are, aim};
    const float nr = are - 1.0f, ni = aim, den = 1.0f / (lr * lr + li * li);
    const float sr = (nr * lr + ni * li) * den, si = (ni * lr - nr * li) * den;
    const float* br = F.in[I_BRE] + (gi * 64 + p) * 16; const float* bi = F.in[I_BIM] + (gi * 64 + p) * 16;
#pragma unroll
    for (int q = 0; q < 4; ++q) { const f32x4 r4 = *(const f32x4*)(br + 4 * q), i4 = *(const f32x4*)(bi + 4 * q);
#pragma unroll
        for (int j = 0; j < 4; ++j) P.b[4 * q + j] = (f32x2){sr * r4[j] - si * i4[j], sr * i4[j] + si * r4[j]}; }
    float xr = are, xi = aim;
#pragma unroll
    for (int s = 0; s < 6; ++s) { const float t2 = xr * xr - xi * xi; xi = 2.0f * xr * xi; xr = t2; }
    a64 = (f32x2){xr, xi};
}
__device__ __forceinline__ void s5_stage_u(const Frame& F, int sp, int g, LAS float* ub) {
    const bf16_t* src = (const bf16_t*)(F.ws + WS_PROJ) + (size_t)(sp * 64 + F.lane) * EVEN_IN + g * 16;
    const u32x4 w0 = *(const u32x4*)src, w1 = *(const u32x4*)(src + 8);
    LAS f32x4* d = (LAS f32x4*)(ub + F.lane * 16);
    d[0] = (f32x4){bflo(w0.x), bfhi(w0.x), bflo(w0.y), bfhi(w0.y)}; d[1] = (f32x4){bflo(w0.z), bfhi(w0.z), bflo(w0.w), bfhi(w0.w)};
    d[2] = (f32x4){bflo(w1.x), bfhi(w1.x), bflo(w1.y), bfhi(w1.y)}; d[3] = (f32x4){bflo(w1.z), bfhi(w1.z), bflo(w1.w), bfhi(w1.w)};
    LDS_WAIT();
}
__device__ __forceinline__ void s5_bu4(const S5Par& P, const LAS float* ub0, int stepf, f32x2 (&bu)[4]) {
    f32x4 u[4][4];
#pragma unroll
    for (int q = 0; q < 4; ++q) { const LAS f32x4* up = (const LAS f32x4*)(ub0 + q * stepf); u[q][0] = up[0]; u[q][1] = up[1]; u[q][2] = up[2]; u[q][3] = up[3]; }
#pragma unroll
    for (int q = 0; q < 4; ++q) {
        f32x2 s0 = P.b[0] * u[q][0][0], s1 = P.b[1] * u[q][0][1], s2 = P.b[2] * u[q][0][2], s3 = P.b[3] * u[q][0][3];
        s0 += P.b[4] * u[q][1][0]; s1 += P.b[5] * u[q][1][1]; s2 += P.b[6] * u[q][1][2]; s3 += P.b[7] * u[q][1][3];
        s0 += P.b[8] * u[q][2][0]; s1 += P.b[9] * u[q][2][1]; s2 += P.b[10] * u[q][2][2]; s3 += P.b[11] * u[q][2][3];
        s0 += P.b[12] * u[q][3][0]; s1 += P.b[13] * u[q][3][1]; s2 += P.b[14] * u[q][3][2]; s3 += P.b[15] * u[q][3][3];
        bu[q] = (s0 + s1) + (s2 + s3);
    }
}
__device__ __forceinline__ f32x2 s5_adv(const f32x2 are2, const f32x2 aim2, const f32x2 h, const f32x2 b) { return are2 * h + (aim2 * (f32x2){h.y, h.x} + b); }
__device__ __forceinline__ void s5_pass1(const Frame& F0, int e) {
    const Frame F = refresh(F0);
    LAS float* ub = (LAS float*)(F.lds + F.wave * 4096);
    float* SST = (float*)(F.ws + WS_SST);
    for (int unit = F.gw; unit < 96 * 64; unit += F.NGW) {
        const int sp = unit >> 6, g = unit & 63;
        s5_stage_u(F, sp, g, ub);
#pragma unroll
        for (int dir = 0; dir < 2; ++dir) {
            S5Par P; f32x2 a64; s5_load_par(F, e, dir, g, P, a64);
            const f32x2 are2 = {P.a.x, P.a.x}, aim2 = {-P.a.y, P.a.y};
            f32x2 h = {0.f, 0.f};
#pragma unroll 1
            for (int ch = 0; ch < 16; ++ch) {
                f32x2 bu[4]; s5_bu4(P, dir == 0 ? ub + ch * 64 : ub + (63 - ch * 4) * 16, dir == 0 ? 16 : -16, bu);
#pragma unroll
                for (int q = 0; q < 4; ++q) h = s5_adv(are2, aim2, h, bu[q]); }
            float* o = SST + ((size_t)(sp * 64 + g) * 2 + dir) * 128;
            o[F.lane] = h.x; o[64 + F.lane] = h.y;
        }
        LDS_WAIT();
    }
}
__device__ __forceinline__ float gelu_tanh(float y) { const float x = 0.7978845608028654f * (y + 0.044715f * y * y * y); const float t = 1.0f - 2.0f * __builtin_amdgcn_rcpf(1.0f + __expf(2.0f * x)); return 0.5f * y * (1.0f + t); }
__device__ __forceinline__ void s5_pass2(const Frame& F0, int e) {
    const Frame F = refresh(F0);
    LAS float* ub = (LAS float*)(F.lds + F.wave * 4096);
    LAS unsigned char* hb = F.lds + 32768 + F.wave * 8704;
    const float* SST = (const float*)(F.ws + WS_SST);
    bf16_t* Zb = (bf16_t*)(F.ws + WS_Z);
    for (int unit = F.gw; unit < 96 * 64; unit += F.NGW) {
        int lane_ = F.lane; asm volatile("" : "+v"(lane_));
        const int lane = lane_, fr = lane & 15, fq = lane >> 4;
        const int sp = unit >> 6, g = unit & 63;
        const bool isctx = sp < 64; const int seq_sp0 = isctx ? (sp & ~3) : 64 + ((sp - 64) & ~15), seq_nsp = isctx ? 4 : 16;
        const int nseq = isctx ? (sp >> 2) : ((sp - 64) >> 4);
        s5_stage_u(F, sp, g, ub);
        f32x4 acc[4];
#pragma unroll
        for (int i = 0; i < 4; ++i) acc[i] = (f32x4){0.f, 0.f, 0.f, 0.f};
#pragma unroll
        for (int dir = 0; dir < 2; ++dir) {
            const int nprev = dir == 0 ? sp - seq_sp0 : seq_sp0 + seq_nsp - 1 - sp;
            f32x2 sv[15];
#pragma unroll
            for (int q = 0; q < 15; ++q) { const int qq = q < nprev ? q : 0; const int ss = dir == 0 ? seq_sp0 + qq : seq_sp0 + seq_nsp - 1 - qq;
                const float* sp_ = SST + ((size_t)(ss * 64 + g) * 2 + dir) * 128; sv[q] = (f32x2){sp_[lane], sp_[64 + lane]}; }
            const size_t si = (size_t)((((nseq & 1) * 2 + e) * 2 + dir) * 64 + g) * 64 + lane;
            f32x2 h = {F.in[I_S5RE][si], F.in[I_S5IM][si]};
            const size_t gi = (size_t)((e * 2 + dir) * 64 + g);
            const float* cr = F.in[I_CRE] + (gi * 16 + fr) * 64 + 4 * fq; const float* ci = F.in[I_CIM] + (gi * 16 + fr) * 64 + 4 * fq;
            bf16x8 cf[4];
#pragma unroll
            for (int ks = 0; ks < 4; ++ks) { const f32x4 crv = *(const f32x4*)(cr + 16 * ks), civ = *(const f32x4*)(ci + 16 * ks);
                u32x4 w; w.x = pk2(crv[0], -civ[0]); w.y = pk2(crv[1], -civ[1]); w.z = pk2(crv[2], -civ[2]); w.w = pk2(crv[3], -civ[3]); cf[ks] = __builtin_bit_cast(bf16x8, w); }
            S5Par P; f32x2 a64; s5_load_par(F, e, dir, g, P, a64);
            if (isctx) h = (f32x2){0.f, 0.f};
            { const f32x2 r2 = {a64.x, a64.x}, i2 = {-a64.y, a64.y};
#pragma unroll
              for (int q = 0; q < 15; ++q) { const f32x2 hn = s5_adv(r2, i2, h, sv[q]); h = q < nprev ? hn : h; } }
            const f32x2 are2 = {P.a.x, P.a.x}, aim2 = {-P.a.y, P.a.y};
#pragma unroll
            for (int sbi = 0; sbi < 2; ++sbi) {
                const int sb = dir == 0 ? sbi : 1 - sbi;
#pragma unroll 1
                for (int ch = 0; ch < 8; ++ch) {
                    const int t0 = dir == 0 ? ch * 4 : 31 - ch * 4;
                    f32x2 bu[4]; s5_bu4(P, ub + (sb * 32 + t0) * 16, dir == 0 ? 16 : -16, bu);
#pragma unroll
                    for (int q = 0; q < 4; ++q) { const int t = dir == 0 ? t0 + q : t0 - q;
                        h = s5_adv(are2, aim2, h, bu[q]);
                        *(LAS unsigned*)(hb + t * 272 + lane * 4) = pk2(h.x, h.y); } }
                LDS_WAIT();
#pragma unroll
                for (int mt = 0; mt < 2; ++mt)
#pragma unroll
                    for (int ks = 0; ks < 4; ++ks) { const bf16x8 af = *(const LAS bf16x8*)(hb + (mt * 16 + fr) * 272 + (8 * fq + 32 * ks) * 2);
                        acc[sb * 2 + mt] = __builtin_amdgcn_mfma_f32_16x16x32_bf16(af, cf[ks], acc[sb * 2 + mt], 0, 0, 0); }
                LDS_WAIT();
            }
            if (isctx && ((dir == 0 && sp == seq_sp0 + 3) || (dir == 1 && sp == seq_sp0))) {
                const size_t oi = (size_t)(((nseq * 2 + e) * 2 + dir) * 64 + g) * 64 + lane;
                F.out[OUT_S5RE + oi] = DBG_SCALE * h.x; F.out[OUT_S5IM + oi] = DBG_SCALE * h.y; }
        }
        const float dsk = F.in[I_S5D][e * 1024 + g * 16 + fr];
#pragma unroll
        for (int tile = 0; tile < 4; ++tile)
#pragma unroll
            for (int r = 0; r < 4; ++r) { const int t = 16 * tile + 4 * fq + r; const float y = acc[tile][r] + dsk * ub[t * 16 + fr];
                *(LAS bf16_t*)(hb + t * 32 + fr * 2) = (bf16_t)f2bf(gelu_tanh(y)); }
        LDS_WAIT();
        { const u32x4 z0 = *(const LAS u32x4*)(hb + lane * 32), z1 = *(const LAS u32x4*)(hb + lane * 32 + 16);
          bf16_t* zp = Zb + (size_t)(sp * 64 + lane) * 1024 + g * 16; st16_wt(zp, z0); st16_wt(zp + 8, z1); }
        LDS_WAIT();
    }
}

constexpr int KS_PITCH = 272, VT_PITCH = 264;
constexpr int ENG_KS = 0, ENG_VT = 128 * KS_PITCH;

__device__ __forceinline__ void stage_k_bf16(LAS unsigned char* Ks, const bf16_t* src, int ld, int tid) {
    const int key = tid >> 2, part = tid & 3;
    const u32x4* s = (const u32x4*)(src + (size_t)key * ld + part * 32);
    const u32x4 a = s[0], b = s[1], c = s[2], d = s[3];
    LAS u32x4* dst = (LAS u32x4*)(Ks + key * KS_PITCH + part * 64);
    dst[0] = a; dst[1] = b; dst[2] = c; dst[3] = d;
}
__device__ __forceinline__ void stage_k_f32(LAS unsigned char* Ks, const float* src, int ld, int tid) {
    const int key = tid >> 2, part = tid & 3;
    const f32x4* s = (const f32x4*)(src + (size_t)key * ld + part * 32);
    LAS u32x4* dst = (LAS u32x4*)(Ks + key * KS_PITCH + part * 64);
#pragma unroll
    for (int q = 0; q < 4; ++q) { const f32x4 a = s[2 * q], b = s[2 * q + 1]; u32x4 w; w.x = pk2(a[0], a[1]); w.y = pk2(a[2], a[3]); w.z = pk2(b[0], b[1]); w.w = pk2(b[2], b[3]); dst[q] = w; }
}
__device__ __forceinline__ void unpack8(const u32x4 w, float* x) { x[0] = bflo(w.x); x[1] = bfhi(w.x); x[2] = bflo(w.y); x[3] = bfhi(w.y); x[4] = bflo(w.z); x[5] = bfhi(w.z); x[6] = bflo(w.w); x[7] = bfhi(w.w); }
__device__ __forceinline__ u32x4 pack8(const float* x) { u32x4 w; w.x = pk2(x[0], x[1]); w.y = pk2(x[2], x[3]); w.z = pk2(x[4], x[5]); w.w = pk2(x[6], x[7]); return w; }
__device__ __forceinline__ void stage_k_rope(LAS unsigned char* Ks, const bf16_t* src, int ld, int t0, const float* rope, int tid) {
    const int key = tid >> 2, part = tid & 3, half = part >> 1, sub = part & 1, t = t0 + key, pos = half ? (t & 63) : (t >> 6);
    const bf16_t* p1 = src + (size_t)key * ld + 64 * half + 16 * sub;
    const u32x4 a0 = *(const u32x4*)p1, a1 = *(const u32x4*)(p1 + 8), b0 = *(const u32x4*)(p1 + 32), b1 = *(const u32x4*)(p1 + 40);
    float x1[16], x2[16], o1[16], o2[16];
    unpack8(a0, x1); unpack8(a1, x1 + 8); unpack8(b0, x2); unpack8(b1, x2 + 8);
    const float* cs = rope + pos * 32 + 16 * sub; const float* sn = cs + 2048;
#pragma unroll
    for (int q = 0; q < 4; ++q) { const f32x4 c4 = *(const f32x4*)(cs + 4 * q), s4 = *(const f32x4*)(sn + 4 * q);
#pragma unroll
        for (int j = 0; j < 4; ++j) { const int i = 4 * q + j; o1[i] = x1[i] * c4[j] - x2[i] * s4[j]; o2[i] = x1[i] * s4[j] + x2[i] * c4[j]; } }
    LAS u32x4* d1 = (LAS u32x4*)(Ks + key * KS_PITCH + (64 * half + 16 * sub) * 2);
    d1[0] = pack8(o1); d1[1] = pack8(o1 + 8); d1[4] = pack8(o2); d1[5] = pack8(o2 + 8);
}
template <bool WEIGHTED>
__device__ __forceinline__ void stage_vt_bf16(LAS unsigned char* Vt, const bf16_t* src, int ld, int tid, float wgt) {
    const int key = tid >> 2, part = tid & 3;
    const u32x4* s = (const u32x4*)(src + (size_t)key * ld + part * 32);
    const u32x4 a = s[0], b = s[1], c = s[2], d = s[3];
    const unsigned w[16] = {a.x, a.y, a.z, a.w, b.x, b.y, b.z, b.w, c.x, c.y, c.z, c.w, d.x, d.y, d.z, d.w};
    LAS unsigned char* dst = Vt + (part * 32) * VT_PITCH + key * 2;
#pragma unroll
    for (int q = 0; q < 16; ++q) {
        if (WEIGHTED) { *(LAS bf16_t*)(dst + (2 * q) * VT_PITCH) = (bf16_t)f2bf(bflo(w[q]) * wgt); *(LAS bf16_t*)(dst + (2 * q + 1) * VT_PITCH) = (bf16_t)f2bf(bfhi(w[q]) * wgt); }
        else { *(LAS bf16_t*)(dst + (2 * q) * VT_PITCH) = (bf16_t)(w[q] & 0xffffu); *(LAS bf16_t*)(dst + (2 * q + 1) * VT_PITCH) = (bf16_t)(w[q] >> 16); } }
}
__device__ __forceinline__ void stage_vt_f32(LAS unsigned char* Vt, const float* src, int ld, int tid) {
    const int key = tid >> 2, part = tid & 3;
    const f32x4* s = (const f32x4*)(src + (size_t)key * ld + part * 32);
    LAS unsigned char* dst = Vt + (part * 32) * VT_PITCH + key * 2;
#pragma unroll
    for (int q = 0; q < 8; ++q) { const f32x4 a = s[q];
#pragma unroll
        for (int j = 0; j < 4; ++j) *(LAS bf16_t*)(dst + (4 * q + j) * VT_PITCH) = (bf16_t)f2bf(a[j]); }
}
__device__ __forceinline__ void qk_tiles(const LAS unsigned char* Ks, int sb, int fr, int fq, const bf16x8 (&qf)[4], f32x4 (&st)[2]) {
#pragma unroll
    for (int tt = 0; tt < 2; ++tt) { st[tt] = (f32x4){0.f, 0.f, 0.f, 0.f};
#pragma unroll
        for (int ks = 0; ks < 4; ++ks) { const bf16x8 kf = *(const LAS bf16x8*)(Ks + (32 * sb + 16 * tt + fr) * KS_PITCH + (8 * fq + 32 * ks) * 2);
            st[tt] = __builtin_amdgcn_mfma_f32_16x16x32_bf16(kf, qf[ks], st[tt], 0, 0, 0); } }
}
__device__ __forceinline__ void pv_step(const LAS unsigned char* Vt, int sb, int fr, int fq, const bf16x8 pf, f32x4 (&o)[8]) {
#pragma unroll
    for (int dt = 0; dt < 8; ++dt) { const LAS unsigned char* vp = Vt + (16 * dt + fr) * VT_PITCH + (32 * sb + 4 * fq) * 2;
        const u32x2 lo = *(const LAS u32x2*)vp, hi = *(const LAS u32x2*)(vp + 32);
        u32x4 w; w.x = lo.x; w.y = lo.y; w.z = hi.x; w.w = hi.y;
        o[dt] = __builtin_amdgcn_mfma_f32_16x16x32_bf16(__builtin_bit_cast(bf16x8, w), pf, o[dt], 0, 0, 0); }
}
__device__ __forceinline__ bf16x8 pack_p(const f32x4 p0, const f32x4 p1) { u32x4 w; w.x = pk2(p0[0], p0[1]); w.y = pk2(p0[2], p0[3]); w.z = pk2(p1[0], p1[1]); w.w = pk2(p1[2], p1[3]); return __builtin_bit_cast(bf16x8, w); }
__device__ __forceinline__ void load_q(const bf16_t* qrow, int fq, bf16x8 (&qf)[4]) {
#pragma unroll
    for (int ks = 0; ks < 4; ++ks) qf[ks] = __builtin_bit_cast(bf16x8, *(const u32x4*)(qrow + 8 * fq + 32 * ks));
}
__device__ __forceinline__ void rope_q(bf16x8 (&qf)[4], int t, int fq, const float* rope) {
#pragma unroll
    for (int half = 0; half < 2; ++half) { const int pos = half ? (t & 63) : (t >> 6);
        float x1[8], x2[8], o1[8], o2[8]; unpack8(__builtin_bit_cast(u32x4, qf[2 * half]), x1); unpack8(__builtin_bit_cast(u32x4, qf[2 * half + 1]), x2);
        const float* cs = rope + pos * 32 + 8 * fq; const float* sn = cs + 2048;
        const f32x4 c0 = *(const f32x4*)cs, c1 = *(const f32x4*)(cs + 4), s0 = *(const f32x4*)sn, s1 = *(const f32x4*)(sn + 4);
#pragma unroll
        for (int j = 0; j < 4; ++j) { o1[j] = x1[j] * c0[j] - x2[j] * s0[j]; o2[j] = x1[j] * s0[j] + x2[j] * c0[j]; o1[4 + j] = x1[4 + j] * c1[j] - x2[4 + j] * s1[j]; o2[4 + j] = x1[4 + j] * s1[j] + x2[4 + j] * c1[j]; }
        qf[2 * half] = __builtin_bit_cast(bf16x8, pack8(o1)); qf[2 * half + 1] = __builtin_bit_cast(bf16x8, pack8(o2)); }
}

struct ChunkRegs { u32x4 k[4], v[4]; };
__device__ __forceinline__ void chunk_load(ChunkRegs& R, const bf16_t* ksrc, const bf16_t* vsrc, int ld, int tid) {
    const int key = tid >> 2, part = tid & 3;
    const GAS u32x4* ks = (const GAS u32x4*)((const GAS bf16_t*)ksrc + (size_t)key * ld + part * 32); const GAS u32x4* vs = (const GAS u32x4*)((const GAS bf16_t*)vsrc + (size_t)key * ld + part * 32);
#pragma unroll
    for (int q = 0; q < 4; ++q) { R.k[q] = ks[q]; R.v[q] = vs[q]; }
}
__device__ __forceinline__ void chunk_write(const ChunkRegs& R, LAS unsigned char* Ks, LAS unsigned char* Vt, int tid) {
    const int key = tid >> 2, part = tid & 3;
    LAS u32x4* kd = (LAS u32x4*)(Ks + key * KS_PITCH + part * 64);
#pragma unroll
    for (int q = 0; q < 4; ++q) kd[q] = R.k[q];
    const unsigned w[16] = {R.v[0].x, R.v[0].y, R.v[0].z, R.v[0].w, R.v[1].x, R.v[1].y, R.v[1].z, R.v[1].w, R.v[2].x, R.v[2].y, R.v[2].z, R.v[2].w, R.v[3].x, R.v[3].y, R.v[3].z, R.v[3].w};
    LAS unsigned char* dst = Vt + (part * 32) * VT_PITCH + key * 2;
#pragma unroll
    for (int q = 0; q < 16; ++q) { *(LAS bf16_t*)(dst + (2 * q) * VT_PITCH) = (bf16_t)(w[q] & 0xffffu); *(LAS bf16_t*)(dst + (2 * q + 1) * VT_PITCH) = (bf16_t)(w[q] >> 16); }
}
__device__ __forceinline__ float log_sigmoid_big(float x) { const float y = __expf(-x); return -(y * (1.0f + y * (-0.5f + y * (0.33333334f + y * (-0.25f + y * 0.2f))))); }
__device__ __forceinline__ void ret_unit(const Frame& F, int e, bool isctx, int n, int h, int qb) {
    LAS unsigned char* Ks = F.lds + ENG_KS; LAS unsigned char* Vt = F.lds + ENG_VT;
    const bf16_t* PROJ = (const bf16_t*)(F.ws + WS_PROJ);
    const int lane = F.lane, fr = lane & 15, fq = lane >> 4;
    const int R0 = isctx ? 256 * n : NCTX + 1024 * n, L = isctx ? 256 : 1024, nkc = L >> 7;
    const int iq = 128 * qb + 16 * F.wave + fr;
    const float lgf = log_sigmoid_big(F.in[I_DECAY][(e * 2 + 0) * 8 + h]), lgb = log_sigmoid_big(F.in[I_DECAY][(e * 2 + 1) * 8 + h]);
    const float kscale = 0.08838834764831845f;
    bf16x8 qf[4]; load_q(PROJ + (size_t)(R0 + iq) * EVEN_IN + 1024 + 128 * h, fq, qf);
    f32x4 o[8];
#pragma unroll
    for (int dt = 0; dt < 8; ++dt) o[dt] = (f32x4){0.f, 0.f, 0.f, 0.f};
    ChunkRegs CR; chunk_load(CR, PROJ + (size_t)R0 * EVEN_IN + 2048 + 128 * h, PROJ + (size_t)R0 * EVEN_IN + 3072 + 128 * h, EVEN_IN, F.tid);
    for (int kc = 0; kc < nkc; ++kc) {
        __syncthreads();
        chunk_write(CR, Ks, Vt, F.tid);
        __syncthreads();
        if (kc + 1 < nkc) chunk_load(CR, PROJ + (size_t)(R0 + 128 * (kc + 1)) * EVEN_IN + 2048 + 128 * h, PROJ + (size_t)(R0 + 128 * (kc + 1)) * EVEN_IN + 3072 + 128 * h, EVEN_IN, F.tid);
#pragma unroll 1
        for (int sb = 0; sb < 4; ++sb) {
            f32x4 st[2]; qk_tiles(Ks, sb, fr, fq, qf, st);
#pragma unroll
            for (int tt = 0; tt < 2; ++tt)
#pragma unroll
                for (int r = 0; r < 4; ++r) { const int j = 128 * kc + 32 * sb + 16 * tt + 4 * fq + r; const int df = iq - j;
                    const float m = df > 0 ? __expf((float)df * lgf) : (df < 0 ? __expf((float)(-df) * lgb) : 2.0f);
                    st[tt][r] *= kscale * m; }
            pv_step(Vt, sb, fr, fq, pack_p(st[0], st[1]), o);
        }
    }
    if (!isctx) {
        const bf16_t* qrow = PROJ + (size_t)(R0 + iq) * EVEN_IN + 1024 + 128 * h;
#pragma unroll 1
        for (int dir = 0; dir < 2; ++dir) {
            __syncthreads();
            stage_vt_f32(Vt, F.in[I_SRET] + (size_t)(((n * 2 + e) * 2 + dir) * 8 + h) * 16384, 128, F.tid);
            __syncthreads();
            const float wq = dir == 0 ? __expf((float)(iq + 1) * lgf) : __expf((float)(L - iq) * lgb);
#pragma unroll 1
            for (int sb = 0; sb < 4; ++sb) {
                const u32x2 lo = *(const u32x2*)(qrow + 32 * sb + 4 * fq), hi = *(const u32x2*)(qrow + 32 * sb + 16 + 4 * fq);
                f32x4 p0 = {bflo(lo.x) * wq, bfhi(lo.x) * wq, bflo(lo.y) * wq, bfhi(lo.y) * wq}, p1 = {bflo(hi.x) * wq, bfhi(hi.x) * wq, bflo(hi.y) * wq, bfhi(hi.y) * wq};
                pv_step(Vt, sb, fr, fq, pack_p(p0, p1), o);
            }
        }
    }
    float s = 0.f;
#pragma unroll
    for (int dt = 0; dt < 8; ++dt) s += (o[dt][0] + o[dt][1]) + (o[dt][2] + o[dt][3]);
    s += __shfl_xor(s, 16); s += __shfl_xor(s, 32);
    const float mu = s * (1.0f / 128.0f); float v = 0.f;
#pragma unroll
    for (int dt = 0; dt < 8; ++dt) { const f32x4 d = o[dt] - mu; v += (d[0] * d[0] + d[1] * d[1]) + (d[2] * d[2] + d[3] * d[3]); }
    v += __shfl_xor(v, 16); v += __shfl_xor(v, 32);
    const float rs = rsqrtf(v * (1.0f / 128.0f) + EPS);
    const bf16_t* grow = PROJ + (size_t)(R0 + iq) * EVEN_IN + 4096 + 128 * h; bf16_t* yrow = (bf16_t*)(F.ws + WS_YCAT) + (size_t)(R0 + iq) * 2048 + 1024 + 128 * h;
    const float* gn = F.in[I_GNG] + e * 1024 + 128 * h;
#pragma unroll
    for (int dt = 0; dt < 8; ++dt) { const int ee = 16 * dt + 4 * fq; const u32x2 gw = *(const u32x2*)(grow + ee); const f32x4 g4 = *(const f32x4*)(gn + ee);
        const float g0 = bflo(gw.x), g1 = bfhi(gw.x), g2 = bflo(gw.y), g3 = bfhi(gw.y);
        u32x2 w; w.x = pk2(siluf_(g0) * ((o[dt][0] - mu) * rs * g4[0]), siluf_(g1) * ((o[dt][1] - mu) * rs * g4[1]));
        w.y = pk2(siluf_(g2) * ((o[dt][2] - mu) * rs * g4[2]), siluf_(g3) * ((o[dt][3] - mu) * rs * g4[3]));
        st8_wt(yrow + ee, w); }
}
__device__ __forceinline__ void ret_final_unit(const Frame& F, int e, int n, int h, int dir) {
    LAS unsigned char* Kt = F.lds + ENG_KS; LAS unsigned char* Vt = F.lds + ENG_VT;
    const bf16_t* PROJ = (const bf16_t*)(F.ws + WS_PROJ);
    const int lane = F.lane, fr = lane & 15, fq = lane >> 4, R0 = 256 * n;
    const float lg = log_sigmoid_big(F.in[I_DECAY][(e * 2 + dir) * 8 + h]);
    f32x4 acc[8];
#pragma unroll
    for (int et = 0; et < 8; ++et) acc[et] = (f32x4){0.f, 0.f, 0.f, 0.f};
    for (int kc = 0; kc < 2; ++kc) {
        __syncthreads();
        { const int j = 128 * kc + (F.tid >> 2); const float wj = 0.08838834764831845f * (dir == 0 ? __expf((float)(255 - j) * lg) : __expf((float)j * lg));
          stage_vt_bf16<true>(Kt, PROJ + (size_t)(R0 + 128 * kc) * EVEN_IN + 2048 + 128 * h, EVEN_IN, F.tid, wj); }
        stage_vt_bf16<false>(Vt, PROJ + (size_t)(R0 + 128 * kc) * EVEN_IN + 3072 + 128 * h, EVEN_IN, F.tid, 1.0f);
        __syncthreads();
#pragma unroll
        for (int ks = 0; ks < 4; ++ks) {
            const LAS unsigned char* kp = Kt + (16 * F.wave + fr) * VT_PITCH + (32 * ks + 8 * fq) * 2;
            const u32x2 k0 = *(const LAS u32x2*)kp, k1 = *(const LAS u32x2*)(kp + 8); u32x4 kw; kw.x = k0.x; kw.y = k0.y; kw.z = k1.x; kw.w = k1.y;
#pragma unroll
            for (int et = 0; et < 8; ++et) { const LAS unsigned char* vp = Vt + (16 * et + fr) * VT_PITCH + (32 * ks + 8 * fq) * 2;
                const u32x2 v0 = *(const LAS u32x2*)vp, v1 = *(const LAS u32x2*)(vp + 8); u32x4 vw; vw.x = v0.x; vw.y = v0.y; vw.z = v1.x; vw.w = v1.y;
                acc[et] = __builtin_amdgcn_mfma_f32_16x16x32_bf16(__builtin_bit_cast(bf16x8, kw), __builtin_bit_cast(bf16x8, vw), acc[et], 0, 0, 0); }
        }
    }
    float* outp = F.out + OUT_RET + (size_t)(((n * 2 + e) * 2 + dir) * 8 + h) * 16384;
#pragma unroll
    for (int et = 0; et < 8; ++et)
#pragma unroll
        for (int r = 0; r < 4; ++r) outp[(size_t)(16 * F.wave + 4 * fq + r) * 128 + 16 * et + fr] = DBG_SCALE * acc[et][r];
}
__device__ __forceinline__ void retention_phase(const Frame& F0, int e) {
    const Frame F = refresh(F0);
    const int b = blockIdx.x;
    { int first, cnt, step; if (F.G == 256) { first = b < 128 ? b : 128 + 2 * (b - 128); cnt = b < 128 ? 1 : 2; step = 1; } else { first = b; cnt = (384 - b + F.G - 1) / F.G; step = F.G; }
#pragma unroll 1
      for (int k = 0; k < cnt; ++k) { const int u = first + k * step; const bool isctx = u >= 128; const int c = u - 128;
          ret_unit(F, e, isctx, isctx ? c >> 4 : u >> 6, isctx ? (c >> 1) & 7 : (u >> 3) & 7, isctx ? c & 1 : u & 7); } }
    for (int u = b; u < 256; u += F.G) ret_final_unit(F, e, u >> 4, (u >> 1) & 7, u & 1);
    __syncthreads();
}

template <bool MASKED>
__device__ __forceinline__ void softmax_block(f32x4 (&st)[2], int iq, int j0  , int fq, float& m, float& l, f32x4 (&o)[8]) {
    const float scale = 0.08838834764831845f;
    float mx = -3.0e38f;
#pragma unroll
    for (int tt = 0; tt < 2; ++tt)
#pragma unroll
        for (int r = 0; r < 4; ++r) { float sv = st[tt][r] * scale;
            if (MASKED) { const int j = j0 + 16 * tt + 4 * fq + r; const int df = j - iq; if (df > 128 || df < -128) sv = -3.0e38f; }
            st[tt][r] = sv; mx = fmaxf(mx, sv); }
    mx = fmaxf(mx, __shfl_xor(mx, 16)); mx = fmaxf(mx, __shfl_xor(mx, 32));
    const float mn = fmaxf(m, mx), alpha = __expf(m - mn);
    float ps = 0.f;
#pragma unroll
    for (int tt = 0; tt < 2; ++tt)
#pragma unroll
        for (int r = 0; r < 4; ++r) { const float p = st[tt][r] > -1.0e38f ? __expf(st[tt][r] - mn) : 0.f; st[tt][r] = p; ps += p; }
    l = l * alpha + ps; m = mn;
#pragma unroll
    for (int dt = 0; dt < 8; ++dt) o[dt] *= alpha;
}
__device__ __forceinline__ void attn_unit(const Frame& F, int oi, bool isctx, int n, int hq, int qb) {
    LAS unsigned char* Ks = F.lds + ENG_KS; LAS unsigned char* Vt = F.lds + ENG_VT;
    const bf16_t* PROJ = (const bf16_t*)(F.ws + WS_PROJ); const float* rope = (const float*)(F.ws + WS_ROPE);
    const int lane = F.lane, fr = lane & 15, fq = lane >> 4, hkv = hq >> 2;
    const int R0 = isctx ? 256 * n : NCTX + 1024 * n;
    const int iq = 128 * qb + 16 * F.wave + fr, iq0 = 128 * qb + 16 * F.wave;
    bf16x8 qf[4]; load_q(PROJ + (size_t)(R0 + iq) * ODD_IN + 1024 + 128 * hq, fq, qf);
    if (!isctx) rope_q(qf, iq, fq, rope);
    f32x4 o[8];
#pragma unroll
    for (int dt = 0; dt < 8; ++dt) o[dt] = (f32x4){0.f, 0.f, 0.f, 0.f};
    float m = F.in[I_SINK][oi * 8 + hq], l = fq == 0 ? 1.0f : 0.0f;
    if (isctx) {
        for (int kc = 0; kc < 2; ++kc) {
            __syncthreads();
            stage_k_bf16(Ks, PROJ + (size_t)(R0 + 128 * kc) * ODD_IN + 2048 + 128 * hkv, ODD_IN, F.tid);
            stage_vt_bf16<false>(Vt, PROJ + (size_t)(R0 + 128 * kc) * ODD_IN + 2304 + 128 * hkv, ODD_IN, F.tid, 1.0f);
            __syncthreads();
#pragma unroll 1
            for (int sb = 0; sb < 4; ++sb) { f32x4 st[2]; qk_tiles(Ks, sb, fr, fq, qf, st); softmax_block<false>(st, iq, 0, fq, m, l, o); pv_step(Vt, sb, fr, fq, pack_p(st[0], st[1]), o); }
        }
    } else {
        for (int kc = qb - 1; kc <= qb + 1; ++kc) {
            if (kc < 0 || kc >= 8) continue;
            __syncthreads();
            stage_k_rope(Ks, PROJ + (size_t)(R0 + 128 * kc) * ODD_IN + 2048 + 128 * hkv, ODD_IN, 128 * kc, rope, F.tid);
            stage_vt_bf16<false>(Vt, PROJ + (size_t)(R0 + 128 * kc) * ODD_IN + 2304 + 128 * hkv, ODD_IN, F.tid, 1.0f);
            __syncthreads();
#pragma unroll 1
            for (int sb = 0; sb < 4; ++sb) { const int j0 = 128 * kc + 32 * sb;
                if (j0 > iq0 + 15 + 128 || j0 + 31 < iq0 - 128) continue;
                f32x4 st[2]; qk_tiles(Ks, sb, fr, fq, qf, st); softmax_block<true>(st, iq, j0, fq, m, l, o); pv_step(Vt, sb, fr, fq, pack_p(st[0], st[1]), o); }
        }
        for (int kc = 0; kc < 2; ++kc) {
            __syncthreads();
            stage_k_f32(Ks, F.in[I_CK] + ((size_t)((n * 2 + oi) * 256 + 128 * kc) * 2 + hkv) * 128, 256, F.tid);
            stage_vt_f32(Vt, F.in[I_CV] + ((size_t)((n * 2 + oi) * 256 + 128 * kc) * 2 + hkv) * 128, 256, F.tid);
            __syncthreads();
#pragma unroll 1
            for (int sb = 0; sb < 4; ++sb) { f32x4 st[2]; qk_tiles(Ks, sb, fr, fq, qf, st); softmax_block<false>(st, iq, 0, fq, m, l, o); pv_step(Vt, sb, fr, fq, pack_p(st[0], st[1]), o); }
        }
    }
    l += __shfl_xor(l, 16); l += __shfl_xor(l, 32);
    const float inv = __builtin_amdgcn_rcpf(l);
    bf16_t* yrow = (bf16_t*)(F.ws + WS_YCAT) + (size_t)(R0 + iq) * 2048 + 1024 + 128 * hq;
#pragma unroll
    for (int dt = 0; dt < 8; ++dt) { u32x2 w; w.x = pk2(o[dt][0] * inv, o[dt][1] * inv); w.y = pk2(o[dt][2] * inv, o[dt][3] * inv); st8_wt(yrow + 16 * dt + 4 * fq, w); }
}
__device__ __forceinline__ void attention_phase(const Frame& F0, int oi) {
    const Frame F = refresh(F0);
    const int b = blockIdx.x;
    { int first, cnt, step; if (F.G == 256) { first = b < 128 ? b : 128 + 2 * (b - 128); cnt = b < 128 ? 1 : 2; step = 1; } else { first = b; cnt = (384 - b + F.G - 1) / F.G; step = F.G; }
#pragma unroll 1
      for (int k = 0; k < cnt; ++k) { const int u = first + k * step; const bool isctx = u >= 128; const int c = u - 128;
          attn_unit(F, oi, isctx, isctx ? c >> 4 : u >> 6, isctx ? (c >> 1) & 7 : (u >> 3) & 7, isctx ? c & 1 : u & 7); } }
    __syncthreads();
}
__device__ __forceinline__ void pool_phase(const Frame& F0) {
    const Frame F = refresh(F0);
    const bf16_t* PROJ = (const bf16_t*)(F.ws + WS_PROJ); bf16_t* Pb = (bf16_t*)(F.ws + WS_Z);
    const int total = MROWS * 128;
    for (int it = blockIdx.x * 512 + F.tid; it < total; it += F.G * 512) {
        const int row = it >> 7, ch = it & 127, gi = ch >> 5, w = 2 << gi;
        const bool isctx = row < NCTX; const int R0 = isctx ? (row & ~255) : NCTX + ((row - NCTX) & ~1023), L = isctx ? 256 : 1024, t = row - R0;
        int lo = t - (w >> 1), hi = t + (w >> 1) - 1; lo = lo < 0 ? 0 : (lo > L - 1 ? L - 1 : lo); hi = hi < 0 ? 0 : (hi > L - 1 ? L - 1 : hi);
        float s[8] = {0.f, 0.f, 0.f, 0.f, 0.f, 0.f, 0.f, 0.f};
        for (int j = lo; j <= hi; ++j) { float x[8]; unpack8(*(const u32x4*)(PROJ + (size_t)(R0 + j) * ODD_IN + 8 * ch), x);
#pragma unroll
            for (int q = 0; q < 8; ++q) s[q] += x[q]; }
        float x[8]; unpack8(*(const u32x4*)(PROJ + (size_t)row * ODD_IN + 8 * ch), x);
        const float ic = __builtin_amdgcn_rcpf((float)(hi - lo + 1));
#pragma unroll
        for (int q = 0; q < 8; ++q) s[q] = s[q] * ic - x[q];
        st16_wt(Pb + (size_t)row * 1024 + 8 * ch, pack8(s));
    }
}

#ifndef REP_CONV
#define REP_CONV 1
#endif
#ifndef REP_MIX
#define REP_MIX 1
#endif
#ifndef REP_GU
#define REP_GU 1
#endif
#ifndef STOP_L
#define STOP_L 9
#endif
#ifndef STOP_S
#define STOP_S 1
#endif
#define PH_BEGIN int L_ = l; unsigned char* W_ = args.ws; asm volatile("" : "+s"(L_), "+s"(W_)); const int E_ = L_ >> 1; (void)E_;
#define GEMM_RUNX(MB_, Aoff, Boff, M_, N_, K_, lda_, ldb_, apn_, EPI, CID) do { pg8::Gemm g{(const bf16_t*)(W_ + (Aoff)), (const bf16_t*)(W_ + (Boff)), (M_), (N_), (K_), (lda_), (ldb_), (apn_)}; \
    pg8::StaticOrder S; S.init((M_), (N_), (int)gridDim.x, (CID), 64 * (MB_)); pg8::gemm_phase<MB_>((LAS unsigned char*)lds_raw, g, S, EPI, F.wave); } while (0)
#define GEMM_RUNM(MB_, Aoff, Boff, N_, K_, lda_, ldb_, apn_, EPI) GEMM_RUNX(MB_, Aoff, Boff, MROWS, N_, K_, lda_, ldb_, apn_, EPI, (int)blockIdx.x)
constexpr int GU_R1 = 2304, GU_U1 = (GU_R1 / 256) * (2 * FF / 256);
#define GEMM_GU(S_) do { EpiSwiglu E1{(bf16_t*)(W_ + WS_ACT)}; GEMM_RUNX(4, WS_H, ws_wgu(L_, S_), GU_R1, 2 * FF, D, D, D, 0, E1, (int)blockIdx.x); \
    EpiSwiglu E2{(bf16_t*)(W_ + WS_ACT) + (size_t)GU_R1 * FF}; const int G_ = (int)gridDim.x; \
    GEMM_RUNX(3, WS_H + (size_t)GU_R1 * D * 2, ws_wgu(L_, S_), MROWS - GU_R1, 2 * FF, D, D, D, 0, E2, (int)((blockIdx.x + G_ - GU_U1 % G_) % G_)); } while (0)
#define GEMM_RUN(Aoff, Boff, N_, K_, lda_, ldb_, apn_, EPI) GEMM_RUNM(4, Aoff, Boff, N_, K_, lda_, ldb_, apn_, EPI)
#define MIX_EVEN { PH_BEGIN; s5_pass1(F, E_); retention_phase(F, E_); } xcd_barrier(bar, F.wave); { PH_BEGIN; s5_pass2(F, E_); } xcd_barrier(bar, F.wave);
#define MIX_ODD { PH_BEGIN; pool_phase(F); attention_phase(F, E_); } xcd_barrier(bar, F.wave);
#if REP_MIX == 2
#define MIX_EVEN2 MIX_EVEN
#define MIX_ODD2 MIX_ODD
#else
#define MIX_EVEN2
#define MIX_ODD2
#endif
#define LAYER_BODY(LL_) { constexpr int l = LL_; \
        { PH_BEGIN; GEMM_GU(0); } \
        xcd_barrier(bar, F.wave); \
        { PH_BEGIN; EpiBf16<0> E{(bf16_t*)(W_ + WS_Y), D, nullptr, nullptr, 0}; GEMM_RUNM(3, WS_ACT, ws_wd(L_, 0), D, FF, FF, FF, 0, E); } \
        xcd_barrier(bar, F.wave); \
        { PH_BEGIN; bf16_t* Xb = (bf16_t*)(W_ + WS_X); if (l == 0) norm_phase<false, true>(F, true, L_, 0, 0.5f, true, L_, 1, args.in[I_XP], args.in[I_XS], Xb); else norm_phase<true, true>(F, true, L_, 0, 0.5f, true, L_, 1, Xb, Xb + (size_t)NCTX * D, Xb); } \
        xcd_barrier(bar, F.wave); \
        if (l == STOP_L && STOP_S == 0) goto done; \
        if ((l & 1) == 0) { \
            { PH_BEGIN; EpiBf16<0> E{(bf16_t*)(W_ + WS_PROJ), EVEN_IN, nullptr, nullptr, 0}; GEMM_RUN(WS_H, ws_win(L_), EVEN_IN, D, D, D, 0, E); } \
            xcd_barrier(bar, F.wave); \
            if (l == STOP_L && STOP_S == 1) goto done; \
            MIX_EVEN MIX_EVEN2 \
            if (l == STOP_L && STOP_S == 2) goto done; \
            { PH_BEGIN; EpiMix<0> E{(bf16_t*)(W_ + WS_YCAT), (const bf16_t*)(W_ + WS_Z), args.in[I_GLUB] + E_ * 1024}; GEMM_RUN(WS_Z, ws_wx(L_), 1024, 1024, 1024, 1024, 0, E); } \
            xcd_barrier(bar, F.wave); \
        } else { \
            { PH_BEGIN; EpiBf16<1> E{(bf16_t*)(W_ + WS_PROJ), ODD_IN, args.out + OUT_K, args.out + OUT_V, E_}; GEMM_RUN(WS_H, ws_win(L_), ODD_IN, D, D, D, 0, E); } \
            xcd_barrier(bar, F.wave); \
            if (l == STOP_L && STOP_S == 1) goto done; \
            MIX_ODD MIX_ODD2 \
            if (l == STOP_L && STOP_S == 2) goto done; \
            { PH_BEGIN; EpiMix<1> E{(bf16_t*)(W_ + WS_YCAT), nullptr, args.in[I_POOLS] + E_ * 1024}; GEMM_RUN(WS_Z, ws_wx(L_), 1024, 256, 1024, 256, 256, E); } \
            xcd_barrier(bar, F.wave); \
        } \
        { PH_BEGIN; EpiBf16<0> E{(bf16_t*)(W_ + WS_Y), D, nullptr, nullptr, 0}; GEMM_RUNM(3, WS_YCAT, ws_wout(L_), D, D, D, D, 0, E); } \
        xcd_barrier(bar, F.wave); \
        { PH_BEGIN; bf16_t* Xb = (bf16_t*)(W_ + WS_X); norm_phase<true, true>(F, true, L_, 1, 1.0f, true, L_, 2, Xb, Xb + (size_t)NCTX * D, Xb); } \
        xcd_barrier(bar, F.wave); \
        if (l == STOP_L && STOP_S == 3) goto done; \
        { PH_BEGIN; GEMM_GU(1); } \
        xcd_barrier(bar, F.wave); \
        { PH_BEGIN; EpiBf16<0> E{(bf16_t*)(W_ + WS_Y), D, nullptr, nullptr, 0}; GEMM_RUNM(3, WS_ACT, ws_wd(L_, 1), D, FF, FF, FF, 0, E); } \
        xcd_barrier(bar, F.wave); \
        { PH_BEGIN; bf16_t* Xb = (bf16_t*)(W_ + WS_X); if (l == 3 && STOP_L > 3) norm_phase<true, false>(F, true, L_, 2, 0.5f, false, 0, 0, Xb, Xb + (size_t)NCTX * D, args.out); else norm_phase<true, true>(F, true, L_, 2, 0.5f, true, L_ + 1, 0, Xb, Xb + (size_t)NCTX * D, Xb); } \
        xcd_barrier(bar, F.wave); \
        if (l == STOP_L && STOP_S == 4) goto done; \
    }
__global__ void __launch_bounds__(512, 2) mega_fwd(Args args) {
    extern __shared__ __attribute__((aligned(16))) unsigned char lds_raw[];
    Frame F;
    F.lds = (LAS unsigned char*)lds_raw;
    F.tid = 0; F.lane = 0; F.gw = 0; F.wave = __builtin_amdgcn_readfirstlane(threadIdx.x >> 6);
    F.G = gridDim.x; F.NGW = F.G * NWAVES;
    F.in = args.in; F.out = args.out; F.ws = args.ws;
    for (int u = threadIdx.x; u < (LDS_BYTES - RING_BYTES) / 4; u += 512) ((LAS unsigned*)(F.lds + RING_BYTES))[u] = 0u;
    __syncthreads();
    XcdBarrier bar = xcd_barrier_post((unsigned*)(args.ws + WS_CTL) + 4096, (volatile LAS unsigned*)(F.lds + MISC_OFF) + 8);

    phase_mod(F);
    for (int rep = 0; rep < REP_CONV; ++rep) phase_convert(F);
    xcd_barrier(bar, F.wave);
    norm_phase<false, false>(F, false, 0, 0, 0.f, true, 0, 0, args.in[I_XP], args.in[I_XS], nullptr, false);
    xcd_barrier(bar, F.wave);

    LAYER_BODY(0) LAYER_BODY(1) LAYER_BODY(2) LAYER_BODY(3)
    done:;
    if (false) { const f32x4* Xs = (const f32x4*)(args.ws + WS_X); for (size_t i = (size_t)blockIdx.x * 512 + F.wave * 64 + lane_id(); i < (size_t)MROWS * D / 4; i += (size_t)gridDim.x * 512) ((f32x4*)args.out)[i] = Xs[i]; }
}

extern "C" void kernel_launch(void* const* d_in, const int* in_sizes, int n_in, void* d_out, int out_size, void* d_ws, size_t ws_size, hipStream_t stream) {
    static int grid = 0;
    if (grid == 0) {
        if (n_in != N_IN || (size_t)out_size != OUT_TOTAL || ws_size < WS_END) { fprintf(stderr, "kernel_launch: unexpected sizes n_in %d out %d ws %zu (need %zu)\n", n_in, out_size, ws_size, (size_t)WS_END); grid = -1; return; }
        int dev = 0, cus = 0, per_cu = 0;
        if (hipGetDevice(&dev) != hipSuccess || hipDeviceGetAttribute(&cus, hipDeviceAttributeMultiprocessorCount, dev) != hipSuccess) { grid = -1; return; }
        if (hipFuncSetAttribute((const void*)mega_fwd, hipFuncAttributeMaxDynamicSharedMemorySize, LDS_BYTES) != hipSuccess) { fprintf(stderr, "kernel_launch: hipFuncSetAttribute failed\n"); grid = -1; return; }
        if (hipOccupancyMaxActiveBlocksPerMultiprocessor(&per_cu, (const void*)mega_fwd, 512, LDS_BYTES) != hipSuccess || per_cu < 1) fprintf(stderr, "kernel_launch: occupancy query says %d\n", per_cu);
        (void)hipGetLastError();
        grid = cus;
    }
    if (grid < 0) return;
    (void)hipMemsetAsync((char*)d_ws + WS_CTL, 0, CTL_ZERO_BYTES, stream);
    Args a{};
    for (int i = 0; i < N_IN; ++i) a.in[i] = (const float*)d_in[i];
    a.out = (float*)d_out; a.ws = (unsigned char*)d_ws; a.ph_lo = 0; a.ph_hi = 1 << 30;
    hipLaunchKernelGGL(mega_fwd, dim3(grid), dim3(512), LDS_BYTES, stream, a);
}
```

```cpp
#include <hip/hip_runtime.h>
#include <stdio.h>
#include <stdint.h>

#define LAS __attribute__((address_space(3)))
#define GAS __attribute__((address_space(1)))
typedef unsigned short bf16_t;
typedef short bf16x8 __attribute__((ext_vector_type(8)));
typedef short bf16x4 __attribute__((ext_vector_type(4)));
typedef float f32x4 __attribute__((ext_vector_type(4)));
typedef float f32x2 __attribute__((ext_vector_type(2)));
typedef unsigned u32x4 __attribute__((ext_vector_type(4)));
typedef unsigned u32x2 __attribute__((ext_vector_type(2)));

constexpr int D = 2048, FF = 5632, DEPTH = 4;
constexpr int NCTX = 4096, NDEC = 2048, MROWS = 6144;
constexpr int NMOD = 9;
constexpr int EVEN_IN = 5120, ODD_IN = 2560;
constexpr float EPS = 1e-6f;
#ifndef DBG_SCALE_V
#define DBG_SCALE_V 1.0f
#endif
constexpr float DBG_SCALE = DBG_SCALE_V;

constexpr size_t OUT_Y = 0;
constexpr size_t OUT_S5RE = (size_t)MROWS * D;
constexpr size_t OUT_S5IM = OUT_S5RE + 262144;
constexpr size_t OUT_RET = OUT_S5IM + 262144;
constexpr size_t OUT_K = OUT_RET + 8388608;
constexpr size_t OUT_V = OUT_K + 2097152;
constexpr size_t OUT_TOTAL = OUT_V + 2097152;

enum { I_XP = 0, I_XS, I_C, I_S5RE, I_S5IM, I_SRET, I_CK, I_CV, I_CCTX, I_WMOD, I_BMOD, I_NORMG, I_F1G, I_F1U, I_F1D, I_F2G, I_F2U, I_F2D,
       I_EWIN, I_EWOUT, I_LAMRE, I_LAMIM, I_LOGDT, I_BRE, I_BIM, I_CRE, I_CIM, I_S5D, I_GLUW, I_GLUB, I_DECAY, I_GNG, I_OWIN, I_OWOUT, I_POOLW, I_POOLS, I_SINK, N_IN };

constexpr size_t MiB = 1u << 20;
constexpr size_t WS_CTL = 0, CTL_ZERO_BYTES = 64 * 1024;
constexpr size_t WS_MOD = 1 * MiB;
constexpr size_t WS_ROPE = 2 * MiB;
constexpr size_t SZ_WGU = (size_t)2 * FF * D * 2, SZ_WD = (size_t)D * FF * 2;
constexpr size_t SZ_WIN_E = (size_t)EVEN_IN * D * 2, SZ_WIN_O = (size_t)ODD_IN * D * 2, SZ_WOUT = (size_t)D * D * 2, SZ_WGLU = (size_t)1024 * 1024 * 2, SZ_WPOOL = (size_t)1024 * 256 * 2;
constexpr size_t WS_W = 4 * MiB;
constexpr size_t SZ_LAYER_FFN = 2 * SZ_WGU + 2 * SZ_WD;
constexpr size_t SZ_LAYER = SZ_LAYER_FFN + SZ_WIN_E + SZ_WOUT + SZ_WGLU;
__host__ __device__ constexpr size_t ws_wgu(int l, int s) { return WS_W + (size_t)l * SZ_LAYER + (size_t)s * (SZ_WGU + SZ_WD); }
__host__ __device__ constexpr size_t ws_wd(int l, int s) { return ws_wgu(l, s) + SZ_WGU; }
__host__ __device__ constexpr size_t ws_win(int l) { return WS_W + (size_t)l * SZ_LAYER + SZ_LAYER_FFN; }
__host__ __device__ constexpr size_t ws_wout(int l) { return ws_win(l) + SZ_WIN_E; }
__host__ __device__ constexpr size_t ws_wx(int l) { return ws_wout(l) + SZ_WOUT; }
constexpr size_t WS_WEND = WS_W + 4 * SZ_LAYER;
constexpr size_t al(size_t x) { return (x + MiB - 1) / MiB * MiB; }
constexpr size_t WS_X = al(WS_WEND);
constexpr size_t WS_Y = WS_X + (size_t)MROWS * D * 4;
constexpr size_t WS_H = WS_Y + (size_t)MROWS * D * 4;
constexpr size_t WS_ACT = WS_H + (size_t)MROWS * D * 2;
constexpr size_t WS_PROJ = WS_ACT + (size_t)MROWS * FF * 2;
constexpr size_t WS_Z = WS_PROJ + (size_t)MROWS * EVEN_IN * 2;
constexpr size_t WS_YCAT = WS_Z + (size_t)MROWS * 1024 * 2;
constexpr size_t WS_SST = WS_YCAT + (size_t)MROWS * D * 2;
constexpr size_t WS_END = WS_SST + (size_t)96 * 64 * 2 * 128 * 4;

constexpr int RING_BYTES = 131072;
constexpr int MISC_OFF = RING_BYTES + 320;
constexpr int LDS_BYTES = 147456;
constexpr int NWAVES = 8;

__device__ __forceinline__ unsigned f2bf(float f) { return (unsigned)__builtin_bit_cast(unsigned short, (__bf16)f); }
typedef __bf16 hwbf16x2 __attribute__((ext_vector_type(2)));
__device__ __forceinline__ unsigned pk2(float lo, float hi) { const f32x2 v = {lo, hi}; return __builtin_bit_cast(unsigned, __builtin_convertvector(v, hwbf16x2)); }
__device__ __forceinline__ float bf2f(unsigned short b) { return __builtin_bit_cast(float, ((unsigned)b) << 16); }
__device__ __forceinline__ float bflo(unsigned w) { return __builtin_bit_cast(float, w << 16); }
__device__ __forceinline__ float bfhi(unsigned w) { return __builtin_bit_cast(float, w & 0xffff0000u); }
__device__ __forceinline__ float wave_sum(float v) {
#pragma unroll
    for (int o = 1; o < 64; o <<= 1) v += __shfl_xor(v, o);
    return v;
}
__device__ __forceinline__ float sigmoidf_(float x) { return __builtin_amdgcn_rcpf(1.0f + __expf(-x)); }
__device__ __forceinline__ float siluf_(float x) { return x * __builtin_amdgcn_rcpf(1.0f + __expf(-x)); }
__device__ __forceinline__ int lane_id() { int l; asm volatile("v_mbcnt_lo_u32_b32 %0, -1, 0\n\tv_mbcnt_hi_u32_b32 %0, -1, %0" : "=v"(l)); return l; }
__device__ __forceinline__ void st16_wt(void* p, u32x4 v) { asm volatile("global_store_dwordx4 %0, %1, off sc1\n\ts_nop 1" :: "v"(p), "v"(v) : "memory"); }
__device__ __forceinline__ void st16_wt(void* p, f32x4 v) { asm volatile("global_store_dwordx4 %0, %1, off sc1\n\ts_nop 1" :: "v"(p), "v"(v) : "memory"); }
__device__ __forceinline__ void st8_wt(void* p, u32x2 v) { asm volatile("global_store_dwordx2 %0, %1, off sc1\n\ts_nop 1" :: "v"(p), "v"(v) : "memory"); }
#define LDS_WAIT() asm volatile("s_waitcnt lgkmcnt(0)" ::: "memory")
#define VM_WAIT() asm volatile("s_waitcnt vmcnt(0)" ::: "memory")

namespace pg8 {
#define PG8_LAS __attribute__((address_space(3)))
constexpr int BM = 256, BK = 64, HALF = 128, HTB = HALF * BK * 2, STAGE_BYTES = 8 * HTB, NXCD = 8, WGM = 8;
__host__ __device__ __forceinline__ int lds_byte(int r, int c) { const int st = (r >> 4) * 2 + (c >> 5), rr = r & 15, cc = c & 31, ob = rr * 64 + cc * 2; return st * 1024 + (ob ^ (((ob >> 9) & 1) << 5)); }
__host__ __device__ __forceinline__ void stage_rc(int b, int& R, int& C) { const int st = b / 1024, sb = b % 1024, swz = sb ^ (((sb >> 9) & 1) << 5); R = (st >> 1) * 16 + swz / 64; C = (st & 1) * 32 + (swz % 64) / 2; }
__host__ __device__ __forceinline__ int perm32(int rho) { const int n = rho >> 4, i = rho & 15; return 8 * (i >> 2) + 4 * n + (i & 3); }

struct Unit { int pm, pn; };
struct Gemm { const bf16_t* A; const bf16_t* Bt; int M, N, K, lda, ldb, a_pn_off; };

struct StaticOrder {
    int nM, nN, nwg, G, c;
    __host__ __device__ void init(int M, int N, int G_, int c_, int bm = BM) { nM = M / bm; nN = N / BM; nwg = nM * nN; G = G_; c = c_; }
    __host__ __device__ bool next(int i, Unit& u) const {
        const long L = (long)i * G + c; if (L >= nwg) return false;
        int wgid = (int)L; { const int q = nwg / NXCD, r = nwg % NXCD, xcd = wgid % NXCD, off = wgid / NXCD; wgid = (xcd < r ? xcd * (q + 1) : r * (q + 1) + (xcd - r) * q) + off; }
        const int nig = WGM * nN, gid = wgid / nig, fm = gid * WGM, gsz = (nM - fm) < WGM ? (nM - fm) : WGM;
        u.pm = fm + ((wgid % nig) % gsz); u.pn = (wgid % nig) / gsz; return true;
    }
};

template <int MB, class Epi>
__device__ __forceinline__ void gemm_phase(PG8_LAS unsigned char* lds, const Gemm g, const StaticOrder& S, const Epi& E, int wave_s) {
    int tid_ = wave_s * 64 + lane_id(); asm volatile("" : "+v"(tid_));
    const int tid = tid_, wid = __builtin_amdgcn_readfirstlane(tid >> 6), lane = tid & 63, wr = wid >> 2, wc = wid & 3, fr = lane & 15, fq = lane >> 4;
    const int K = g.K, nt = K / BK;
    unsigned voffA[2], voffB[2];
#pragma unroll
    for (int i = 0; i < 2; ++i) { int R, C; stage_rc(tid * 16 + i * 8192, R, C); const int Rb = (R & ~31) + perm32(R & 31);
        voffA[i] = (unsigned)(R * g.lda + C) * 2u; voffB[i] = (unsigned)(Rb * g.ldb + C) * 2u; }
    const size_t kstep = (size_t)(BK * 2);
    const size_t hstepA = (size_t)(32 * MB) * g.lda * 2, hstepB = (size_t)HALF * g.ldb * 2;
    const size_t tstepA = 2 * hstepA, tstepB = 2 * hstepB;
    const unsigned ldsw = (unsigned)wid * 1024u;
    const int aoff = lds_byte(wr * 16 * MB + fr, fq * 8), boff = lds_byte(wc * 32 + fr, fq * 8);
#define PG8_SA(b, h) (((b) * 2 + (h)) * HTB)
#define PG8_SB(b, h) ((4 + (b) * 2 + (h)) * HTB)
#define PG8_STAGE(bufoff, gbase, voff) do { _Pragma("unroll") for (int _i = 0; _i < 2; ++_i) \
        __builtin_amdgcn_global_load_lds((const unsigned*)((const char*)(gbase) + (voff)[_i]), (PG8_LAS unsigned*)(lds + (bufoff) + ldsw + _i * 8192), 16, 0, 0); } while (0)
#define PG8_LDA(dst, b, h) do { _Pragma("unroll") for (int m = 0; m < MB; ++m) _Pragma("unroll") for (int k = 0; k < 2; ++k) dst[m][k] = *(const PG8_LAS bf16x8*)(lds + PG8_SA(b, h) + aoff + m * 2048 + k * 1024); } while (0)
#define PG8_LDB(dst, b, h) do { _Pragma("unroll") for (int n = 0; n < 2; ++n) _Pragma("unroll") for (int k = 0; k < 2; ++k) dst[n][k] = *(const PG8_LAS bf16x8*)(lds + PG8_SB(b, h) + boff + n * 2048 + k * 1024); } while (0)
#define PG8_MMA(ai, bj, At, Bt) do { __builtin_amdgcn_s_setprio(1); _Pragma("unroll") for (int m = 0; m < MB; ++m) _Pragma("unroll") for (int n = 0; n < 2; ++n) _Pragma("unroll") for (int k = 0; k < 2; ++k) \
        acc[ai][bj][m][n] = __builtin_amdgcn_mfma_f32_16x16x32_bf16(Bt[n][k], At[m][k], acc[ai][bj][m][n], 0, 0, 0); __builtin_amdgcn_s_setprio(0); } while (0)
#define PG8_WAIT_V(n) asm volatile("s_waitcnt vmcnt(" #n ")" ::: "memory")
#define PG8_WAIT_L(n) asm volatile("s_waitcnt lgkmcnt(" #n ")" ::: "memory")
#define PG8_BAR __builtin_amdgcn_s_barrier()
#define PG8_SCHED __builtin_amdgcn_sched_barrier(0)
    Unit cur, nxt; int ui = 0;
    if (!S.next(0, cur)) return;
    f32x4 acc[2][2][MB][2];
#pragma unroll
    for (int a = 0; a < 2; ++a)
#pragma unroll
        for (int b = 0; b < 2; ++b)
#pragma unroll
            for (int m = 0; m < MB; ++m)
#pragma unroll
                for (int n = 0; n < 2; ++n) acc[a][b][m][n] = (f32x4){0.f, 0.f, 0.f, 0.f};
    bf16x8 At[MB][2], B0[2][2], B1[2][2];
    const char* cA = (const char*)g.A + (size_t)cur.pm * tstepA + (size_t)cur.pn * g.a_pn_off * 2; const char* cB = (const char*)g.Bt + (size_t)cur.pn * tstepB;
    PG8_STAGE(PG8_SB(0, 0), cB, voffB); PG8_STAGE(PG8_SB(0, 1), cB + hstepB, voffB); PG8_STAGE(PG8_SA(0, 0), cA, voffA); PG8_STAGE(PG8_SA(0, 1), cA + hstepA, voffA);
    if (wr == 1) PG8_BAR;
    PG8_WAIT_V(2); PG8_BAR;
    PG8_STAGE(PG8_SB(1, 0), cB + kstep, voffB); PG8_STAGE(PG8_SA(1, 0), cA + kstep, voffA); PG8_STAGE(PG8_SB(1, 1), cB + hstepB + kstep, voffB);
    PG8_WAIT_V(6); PG8_BAR;
    for (;;) {
        const bool has_next = S.next(ui + 1, nxt);
        const char* nA = has_next ? (const char*)g.A + (size_t)nxt.pm * tstepA + (size_t)nxt.pn * g.a_pn_off * 2 : cA; const char* nB = has_next ? (const char*)g.Bt + (size_t)nxt.pn * tstepB : cB;
        for (int t = 0; t < nt; t += 2) {
            const bool last = (t == nt - 2);
            const char* a1 = cA + (size_t)(t + 1) * kstep;
            const char* a2 = last ? nA : cA + (size_t)(t + 2) * kstep; const char* b2 = last ? nB : cB + (size_t)(t + 2) * kstep;
            const char* a3 = a2 + kstep; const char* b3 = b2 + kstep;
            PG8_LDB(B0, 0, 0); PG8_LDB(B1, 0, 1); PG8_SCHED; PG8_LDA(At, 0, 0); PG8_STAGE(PG8_SA(1, 1), a1 + hstepA, voffA);
            PG8_WAIT_V(8); PG8_WAIT_L(0); PG8_BAR; PG8_MMA(0, 0, At, B0); PG8_MMA(0, 1, At, B1); PG8_BAR; PG8_SCHED;
            PG8_LDA(At, 0, 1); PG8_STAGE(PG8_SB(0, 0), b2, voffB); PG8_STAGE(PG8_SB(0, 1), b2 + hstepB, voffB); PG8_STAGE(PG8_SA(0, 0), a2, voffA);
            PG8_WAIT_V(8); PG8_WAIT_L(0); PG8_BAR; PG8_MMA(1, 0, At, B0); PG8_MMA(1, 1, At, B1); PG8_BAR; PG8_SCHED;
            PG8_LDB(B0, 1, 0); PG8_LDB(B1, 1, 1); PG8_SCHED; PG8_LDA(At, 1, 0); PG8_STAGE(PG8_SA(0, 1), a2 + hstepA, voffA);
            PG8_WAIT_V(8); PG8_WAIT_L(0); PG8_BAR; PG8_MMA(0, 0, At, B0); PG8_MMA(0, 1, At, B1); PG8_BAR; PG8_SCHED;
            PG8_LDA(At, 1, 1); PG8_STAGE(PG8_SB(1, 0), b3, voffB); PG8_STAGE(PG8_SB(1, 1), b3 + hstepB, voffB); PG8_STAGE(PG8_SA(1, 0), a3, voffA);
            PG8_WAIT_V(8); PG8_WAIT_L(0); PG8_BAR; PG8_MMA(1, 0, At, B0); PG8_MMA(1, 1, At, B1); PG8_BAR; PG8_SCHED;
        }
        if (wr == 0) PG8_BAR;
        E(acc, cur, wr, wc, fr, fq);
        if (!has_next) break;
#pragma unroll
        for (int a = 0; a < 2; ++a)
#pragma unroll
            for (int b = 0; b < 2; ++b)
#pragma unroll
                for (int m = 0; m < MB; ++m)
#pragma unroll
                    for (int n = 0; n < 2; ++n) acc[a][b][m][n] = (f32x4){0.f, 0.f, 0.f, 0.f};
        cur = nxt; cA = nA; cB = nB; ++ui;
        if (wr == 1) PG8_BAR;
    }
    PG8_WAIT_V(0);
    PG8_BAR;
#undef PG8_SA
#undef PG8_SB
#undef PG8_STAGE
#undef PG8_LDA
#undef PG8_LDB
#undef PG8_MMA
#undef PG8_WAIT_V
#undef PG8_WAIT_L
#undef PG8_BAR
#undef PG8_SCHED
}
}

struct EpiF32 {
    float* C; int ldc;
    template <int MB> __device__ __forceinline__ void operator()(const f32x4 (&acc)[2][2][MB][2], const pg8::Unit& u, int wr, int wc, int fr, int fq) const {
        const int row0 = u.pm * (64 * MB) + wr * (16 * MB) + fr, col0 = u.pn * 256 + wc * 32 + 8 * fq;
#pragma unroll
        for (int ai = 0; ai < 2; ++ai)
#pragma unroll
            for (int m = 0; m < MB; ++m) { float* rowp = C + (size_t)(row0 + ai * (32 * MB) + m * 16) * ldc + col0;
#pragma unroll
                for (int bj = 0; bj < 2; ++bj) { *(f32x4*)(rowp + bj * 128) = acc[ai][bj][m][0]; *(f32x4*)(rowp + bj * 128 + 4) = acc[ai][bj][m][1]; } }
    }
};
struct EpiSwiglu {
    bf16_t* O;
    template <int MB> __device__ __forceinline__ void operator()(const f32x4 (&acc)[2][2][MB][2], const pg8::Unit& u, int wr, int wc, int fr, int fq) const {
        const int row0 = u.pm * (64 * MB) + wr * (16 * MB) + fr, col0 = u.pn * 128 + wc * 32 + 8 * fq;
#pragma unroll
        for (int ai = 0; ai < 2; ++ai)
#pragma unroll
            for (int m = 0; m < MB; ++m) { bf16_t* rowp = O + (size_t)(row0 + ai * (32 * MB) + m * 16) * FF + col0;
                const f32x4 g0 = acc[ai][0][m][0], g1 = acc[ai][0][m][1], u0 = acc[ai][1][m][0], u1 = acc[ai][1][m][1];
                u32x4 w; w.x = pk2(siluf_(g0[0]) * u0[0], siluf_(g0[1]) * u0[1]); w.y = pk2(siluf_(g0[2]) * u0[2], siluf_(g0[3]) * u0[3]);
                w.z = pk2(siluf_(g1[0]) * u1[0], siluf_(g1[1]) * u1[1]); w.w = pk2(siluf_(g1[2]) * u1[2], siluf_(g1[3]) * u1[3]);
                st16_wt(rowp, w); }
    }
};
template <int MODE> struct EpiBf16 {
    bf16_t* O; int ldc; float* outk; float* outv; int o;
    template <int MB> __device__ __forceinline__ void operator()(const f32x4 (&acc)[2][2][MB][2], const pg8::Unit& u, int wr, int wc, int fr, int fq) const {
        const int row0 = u.pm * (64 * MB) + wr * (16 * MB) + fr, col0 = u.pn * 256 + wc * 32 + 8 * fq;
#pragma unroll
        for (int ai = 0; ai < 2; ++ai)
#pragma unroll
            for (int m = 0; m < MB; ++m) { const int row = row0 + ai * (32 * MB) + m * 16; bf16_t* rowp = O + (size_t)row * ldc + col0;
#pragma unroll
                for (int bj = 0; bj < 2; ++bj) { const f32x4 v0 = acc[ai][bj][m][0], v1 = acc[ai][bj][m][1];
                    u32x4 w; w.x = pk2(v0[0], v0[1]); w.y = pk2(v0[2], v0[3]); w.z = pk2(v1[0], v1[1]); w.w = pk2(v1[2], v1[3]);
                    st16_wt(rowp + bj * 128, w);
                    if (MODE == 1) { if (u.pn >= 8 && row < NCTX) { float* dst = (u.pn == 8 ? outk : outv) + ((size_t)((row >> 8) * 2 + o) * 256 + (row & 255)) * 256 + (col0 - u.pn * 256) + bj * 128;
                        *(f32x4*)dst = DBG_SCALE * v0; *(f32x4*)(dst + 4) = DBG_SCALE * v1; } } } }
    }
};
template <int MODE> struct EpiMix {
    bf16_t* O; const bf16_t* Zb; const float* vec;
    template <int MB> __device__ __forceinline__ void operator()(const f32x4 (&acc)[2][2][MB][2], const pg8::Unit& u, int wr, int wc, int fr, int fq) const {
        const int row0 = u.pm * (64 * MB) + wr * (16 * MB) + fr, col0 = u.pn * 256 + wc * 32 + 8 * fq;
        f32x4 bv[2][2];
#pragma unroll
        for (int bj = 0; bj < 2; ++bj) { bv[bj][0] = *(const f32x4*)(vec + col0 + bj * 128); bv[bj][1] = *(const f32x4*)(vec + col0 + bj * 128 + 4); }
#pragma unroll
        for (int ai = 0; ai < 2; ++ai)
#pragma unroll
            for (int m = 0; m < MB; ++m) { const int row = row0 + ai * (32 * MB) + m * 16; bf16_t* rowp = O + (size_t)row * 2048 + col0;
#pragma unroll
                for (int bj = 0; bj < 2; ++bj) { f32x4 v0 = acc[ai][bj][m][0], v1 = acc[ai][bj][m][1];
                    if (MODE == 0) { const u32x4 zz = *(const u32x4*)(Zb + (size_t)row * 1024 + col0 + bj * 128);
                        v0 += bv[bj][0]; v1 += bv[bj][1];
                        v0[0] = bflo(zz.x) * sigmoidf_(v0[0]); v0[1] = bfhi(zz.x) * sigmoidf_(v0[1]); v0[2] = bflo(zz.y) * sigmoidf_(v0[2]); v0[3] = bfhi(zz.y) * sigmoidf_(v0[3]);
                        v1[0] = bflo(zz.z) * sigmoidf_(v1[0]); v1[1] = bfhi(zz.z) * sigmoidf_(v1[1]); v1[2] = bflo(zz.w) * sigmoidf_(v1[2]); v1[3] = bfhi(zz.w) * sigmoidf_(v1[3]); }
                    else { v0 *= bv[bj][0]; v1 *= bv[bj][1]; }
                    u32x4 w; w.x = pk2(v0[0], v0[1]); w.y = pk2(v0[2], v0[3]); w.z = pk2(v1[0], v1[1]); w.w = pk2(v1[2], v1[3]);
                    st16_wt(rowp + bj * 128, w); } }
    }
};

#define XB_TMO      128
#define XB_XCNT(j)  (256  + 64 * (j))
#define XB_XSUB(j)  (1280 + 64 * (j))
#define XB_XGEN(j)  (2304 + 64 * (j))
#define XB_TOP      3328
#define XB_TOPGEN   3392
#define XCD_BAR_WORDS 3456
#define XB_SPIN_CAP (1u << 18)
__device__ __forceinline__ unsigned xb_ld(unsigned* p)              { return __hip_atomic_load(p, __ATOMIC_RELAXED, __HIP_MEMORY_SCOPE_AGENT); }
__device__ __forceinline__ unsigned xb_add(unsigned* p, unsigned v) { return __hip_atomic_fetch_add(p, v, __ATOMIC_RELAXED, __HIP_MEMORY_SCOPE_AGENT); }
__device__ __forceinline__ unsigned xb_xcc_id() { return (unsigned)__builtin_amdgcn_s_getreg((3 << 11) | 20) & 0xFu; }
#define XB_SPIN(cond, bar) do { unsigned _sp = 0; while (cond) { __builtin_amdgcn_s_sleep(1); \
    if ((++_sp & 255u) == 0u) { if (xb_ld(&(bar)[XB_TMO])) break; if (_sp > XB_SPIN_CAP) { atomicAdd(&(bar)[XB_TMO], 1u); break; } } } } while (0)
struct XcdBarrier { unsigned* bar; unsigned x; volatile LAS unsigned* st; };
__device__ __forceinline__ XcdBarrier xcd_barrier_post(unsigned* bar, volatile LAS unsigned* st) {
    XcdBarrier b; b.bar = bar; b.x = xb_xcc_id(); b.st = st;
    if (threadIdx.x == 0) (void)xb_add(&bar[XB_XCNT(b.x)], 1u);
    return b;
}
__device__ __forceinline__ void xcd_barrier_complete(unsigned* bar, unsigned x, unsigned& nloc, unsigned& nx) {
    const unsigned G = gridDim.x * gridDim.y * gridDim.z;
    unsigned sum, cnt, mine, sp = 0u;
    for (;;) {
        sum = 0u; cnt = 0u; mine = 0u;
#pragma unroll
        for (unsigned j = 0; j < 16; ++j) { const unsigned c = xb_ld(&bar[XB_XCNT(j)]); sum += c; cnt += (c > 0u) ? 1u : 0u; mine = (j == x) ? c : mine; }
        if (sum == G) break;
        __builtin_amdgcn_s_sleep(1);
        if ((++sp & 255u) == 0u) { if (xb_ld(&bar[XB_TMO])) break; if (sp > XB_SPIN_CAP) { atomicAdd(&bar[XB_TMO], 1u); break; } }
    }
    nloc = mine > 0u ? mine : 1u; nx = cnt > 0u ? cnt : 1u;
}
__device__ __forceinline__ void xcd_barrier(const XcdBarrier& b, int wave_s) {
    asm volatile("s_waitcnt vmcnt(0)" ::: "memory");
    __syncthreads();
    if (wave_s == 0 && lane_id() == 0) {
        unsigned* bar = b.bar; unsigned bx = b.x; asm volatile("" : "+s"(bar), "+s"(bx));
        __builtin_amdgcn_s_waitcnt(0);
        unsigned nloc = b.st[0], nx = b.st[1];
        if (nloc == 0u) { xcd_barrier_complete(bar, bx, nloc, nx); b.st[0] = nloc; b.st[1] = nx; }
        const unsigned old = xb_add(&bar[XB_XSUB(bx)], 1u);
        const unsigned gen = old / nloc;
        if (old + 1u == (gen + 1u) * nloc) {
            __builtin_amdgcn_fence(__ATOMIC_RELEASE, "agent");
            asm volatile("s_waitcnt vmcnt(0)" ::: "memory");
            const unsigned og = xb_add(&bar[XB_TOP], 1u);
            const unsigned tg = og / nx;
            if (og + 1u == (tg + 1u) * nx) xb_add(&bar[XB_TOPGEN], 1u);
            else XB_SPIN(xb_ld(&bar[XB_TOPGEN]) == tg, bar);
            __builtin_amdgcn_fence(__ATOMIC_ACQUIRE, "agent");
            xb_add(&bar[XB_XGEN(bx)], 1u);
            asm volatile("s_waitcnt vmcnt(0)" ::: "memory");
        } else {
            XB_SPIN(xb_ld(&bar[XB_XGEN(bx)]) == gen, bar);
            __builtin_amdgcn_fence(__ATOMIC_ACQUIRE, "agent");
            asm volatile("s_waitcnt vmcnt(0)" ::: "memory");
        }
    }
    __syncthreads();
}

struct Args { const float* in[N_IN]; float* out; unsigned char* ws; int ph_lo, ph_hi; };
struct Frame {
    LAS unsigned char* lds;
    int tid, lane, wave, G, gw, NGW;
    const float* const* in;
    float* out; unsigned char* ws;
};
__device__ __forceinline__ Frame refresh(const Frame& F0) {
    Frame F = F0; int ln = lane_id(); asm volatile("" : "+v"(ln));
    F.lane = ln; F.tid = F0.wave * 64 + ln; F.gw = blockIdx.x * NWAVES + F0.wave;
    return F;
}

struct ConvJob { int in_idx; unsigned src_off; int K, N; unsigned long long dst_off; int ldd; int map; int row_off; };
constexpr int NJOBS = 4 * 6 + 2 * 3 + 2 * 6;
struct ConvTable { ConvJob j[NJOBS]; int cum[NJOBS + 1]; };
constexpr ConvTable make_conv_table() {
    ConvTable t{}; int n = 0;
    for (int l = 0; l < DEPTH; ++l) {
        for (int s = 0; s < 2; ++s) {
            const int ig = s ? I_F2G : I_F1G, iu = s ? I_F2U : I_F1U, id = s ? I_F2D : I_F1D;
            t.j[n++] = ConvJob{ig, (unsigned)((size_t)l * D * FF), D, FF, ws_wgu(l, s), D, 1, 0};
            t.j[n++] = ConvJob{iu, (unsigned)((size_t)l * D * FF), D, FF, ws_wgu(l, s), D, 2, 0};
            t.j[n++] = ConvJob{id, (unsigned)((size_t)l * FF * D), FF, D, ws_wd(l, s), FF, 0, 0};
        }
        const int e = l >> 1;
        if ((l & 1) == 0) {
            t.j[n++] = ConvJob{I_EWIN, (unsigned)((size_t)e * D * EVEN_IN), D, EVEN_IN, ws_win(l), D, 0, 0};
            t.j[n++] = ConvJob{I_EWOUT, (unsigned)((size_t)e * D * D), D, D, ws_wout(l), D, 0, 0};
            t.j[n++] = ConvJob{I_GLUW, (unsigned)((size_t)e * 1024 * 1024), 1024, 1024, ws_wx(l), 1024, 0, 0};
        } else {
            t.j[n++] = ConvJob{I_OWIN, (unsigned)((size_t)e * D * ODD_IN), D, ODD_IN, ws_win(l), D, 0, 0};
            t.j[n++] = ConvJob{I_OWOUT, (unsigned)((size_t)e * D * D), D, D, ws_wout(l), D, 0, 0};
            for (int g = 0; g < 4; ++g) t.j[n++] = ConvJob{I_POOLW, (unsigned)((size_t)(e * 4 + g) * 256 * 256), 256, 256, ws_wx(l), 256, 0, g * 256};
        }
    }
    int c = 0;
    for (int i = 0; i < NJOBS; ++i) { t.cum[i] = c; c += (t.j[i].K / 64) * (t.j[i].N / 64); }
    t.cum[NJOBS] = c;
    return t;
}
__device__ const ConvTable g_conv = make_conv_table();

__device__ __forceinline__ void conv_tile(const float* src, int N, int k0, int n0, bf16_t* dst, int ldd, int drow0, LAS unsigned char* scr, int lane) {
    f32x4 v[16];
    const GAS float* sp = (const GAS float*)src + (size_t)(k0 + 2 * (lane >> 4)) * N + n0 + 4 * (lane & 15);
#pragma unroll
    for (int i = 0; i < 16; ++i) v[i] = __builtin_nontemporal_load((const GAS f32x4*)(sp + (size_t)((i & 1) + 8 * (i >> 1)) * N));
#pragma unroll
    for (int i = 0; i < 16; i += 2) { const int k = 2 * (lane >> 4) + 8 * (i >> 1);
#pragma unroll
        for (int j = 0; j < 4; ++j) { const int n = 4 * (lane & 15) + j; *(LAS unsigned*)(scr + n * 144 + k * 2) = pk2(v[i][j], v[i + 1][j]); } }
    LDS_WAIT();
#pragma unroll
    for (int i = 0; i < 8; ++i) { const int q = lane + 64 * i, n = q >> 3, c = q & 7;
        const u32x4 w = *(const LAS u32x4*)(scr + n * 144 + c * 16);
        *(GAS u32x4*)((GAS bf16_t*)dst + (size_t)(drow0 + n) * ldd + k0 + 8 * c) = w; }
    LDS_WAIT();
}

__device__ __forceinline__ void phase_convert(const Frame& F0) {
    const Frame F = refresh(F0);
    LAS unsigned char* scr = F.lds + F.wave * 9216;
    const int total = g_conv.cum[NJOBS];
    int j = NJOBS - 1;
    for (int tq = F.gw; tq < total; tq += F.NGW) {
        const int t = total - 1 - tq;
        while (t < g_conv.cum[j]) --j;
        const ConvJob jb = g_conv.j[j];
        const int r = t - g_conv.cum[j], nbN = jb.N >> 6, kb = r / nbN, nb = r - kb * nbN, n0 = nb * 64;
        const int drow0 = jb.map == 0 ? jb.row_off + n0 : (256 * (n0 >> 7) + (n0 & 127) + (jb.map == 2 ? 128 : 0));
        conv_tile(F.in[jb.in_idx] + jb.src_off, jb.N, kb * 64, n0, (bf16_t*)(F.ws + jb.dst_off), jb.ldd, drow0, scr, F.lane);
    }
}

__device__ __forceinline__ void phase_mod(const Frame& F0) {
    const Frame F = refresh(F0);
    LAS float* sc = (LAS float*)(F.lds + 73728);
    LAS float* red = (LAS float*)(F.lds + 73728 + 24576);
    const float* cctx = F.in[I_CCTX]; const float* cdec = F.in[I_C];
    for (int idx = F.tid; idx < 3 * D; idx += 512) { const int set = idx >> 11, k = idx & 2047; const float v = set == 0 ? cctx[k] : cdec[(set - 1) * D + k]; sc[idx] = v / (1.0f + __expf(-v)); }
    __syncthreads();
    float* MOD = (float*)(F.ws + WS_MOD);
    for (int item = blockIdx.x; item < 256; item += F.G) {
        const int l = item >> 6, col0 = (item & 63) * 288;
        if (F.tid < 504) {
            const int cg = F.tid % 72, kg = F.tid / 72;
            f32x4 a0 = {0.f, 0.f, 0.f, 0.f}, a1 = a0, a2 = a0;
            const float* W = F.in[I_WMOD] + (size_t)l * D * (NMOD * D) + col0 + cg * 4;
#pragma unroll 8
            for (int k = kg; k < D; k += 7) { const f32x4 w = *(const f32x4*)(W + (size_t)k * (NMOD * D)); a0 += sc[k] * w; a1 += sc[2048 + k] * w; a2 += sc[4096 + k] * w; }
            LAS float* rp = red + (kg * 72 + cg) * 12;
            *(LAS f32x4*)rp = a0; *(LAS f32x4*)(rp + 4) = a1; *(LAS f32x4*)(rp + 8) = a2;
        }
        __syncthreads();
        for (int o = F.tid; o < 864; o += 512) { const int set = o / 288, cc = o % 288, cg = cc >> 2, jj = cc & 3; float s = F.in[I_BMOD][(size_t)l * (NMOD * D) + col0 + cc];
#pragma unroll
            for (int kg = 0; kg < 7; ++kg) s += red[(kg * 72 + cg) * 12 + set * 4 + jj];
            MOD[(size_t)(l * 3 + set) * (NMOD * D) + col0 + cc] = s; }
        __syncthreads();
    }
    if (blockIdx.x == 0) { float* rt = (float*)(F.ws + WS_ROPE);
        for (int idx = F.tid; idx < 2048; idx += 512) { const int pos = idx >> 5, i = idx & 31; const float fr = powf(10000.0f, -(float)i / 32.0f); const float ang = (float)pos * fr;
            rt[idx] = cosf(ang); rt[2048 + idx] = sinf(ang); } }
}

template <bool XIN_BF, bool XOUT_BF>
__device__ __forceinline__ void norm_phase(const Frame& F0, bool has_post, int l_post, int j_post, float wpost, bool has_pre, int l_pre, int j_pre,
                                           const void* xs_ctx, const void* xs_dec, void* xdst, bool store_x = true) {
    const Frame F = refresh(F0);
    const float* MOD = (const float*)(F.ws + WS_MOD); const bf16_t* Yb = (const bf16_t*)(F.ws + WS_Y); bf16_t* Hb = (bf16_t*)(F.ws + WS_H);
    const float* ng = F.in[I_NORMG];
    for (int row = F.gw; row < MROWS; row += F.NGW) {
        const int set = row < NCTX ? 0 : 1 + ((row - NCTX) >> 10);
        f32x4 x[8];
        if (XIN_BF) { const GAS bf16_t* xr = row < NCTX ? (const GAS bf16_t*)xs_ctx + (size_t)row * D : (const GAS bf16_t*)xs_dec + (size_t)(row - NCTX) * D;
#pragma unroll
            for (int j = 0; j < 8; ++j) { const u32x2 xw = *(const GAS u32x2*)(xr + 4 * F.lane + 256 * j); x[j] = (f32x4){bflo(xw.x), bfhi(xw.x), bflo(xw.y), bfhi(xw.y)}; } }
        else { const GAS float* xr = row < NCTX ? (const GAS float*)xs_ctx + (size_t)row * D : (const GAS float*)xs_dec + (size_t)(row - NCTX) * D;
#pragma unroll
            for (int j = 0; j < 8; ++j) x[j] = *(const GAS f32x4*)(xr + 4 * F.lane + 256 * j); }
        if (has_post) {
            f32x4 y[8]; float ss = 0.f;
#pragma unroll
            for (int j = 0; j < 8; ++j) { const u32x2 yw = *(const u32x2*)(Yb + (size_t)row * D + 4 * F.lane + 256 * j); y[j] = (f32x4){bflo(yw.x), bfhi(yw.x), bflo(yw.y), bfhi(yw.y)}; ss += (y[j][0] * y[j][0] + y[j][1] * y[j][1]) + (y[j][2] * y[j][2] + y[j][3] * y[j][3]); }
            const float ry = rsqrtf(wave_sum(ss) * (1.0f / D) + EPS);
            const float* gate = MOD + (size_t)((l_post * 3 + set) * NMOD + 3 * j_post + 2) * D; const float* gp = ng + (size_t)(l_post * 6 + 2 * j_post + 1) * D;
#pragma unroll
            for (int j = 0; j < 8; ++j) { const f32x4 gt = *(const f32x4*)(gate + 4 * F.lane + 256 * j), gg = *(const f32x4*)(gp + 4 * F.lane + 256 * j);
                x[j] += wpost * gt * ((y[j] * ry) * gg); }
        }
        if (store_x) {
            if (XOUT_BF) {
#pragma unroll
                for (int j = 0; j < 8; ++j) { u32x2 w; w.x = pk2(x[j][0], x[j][1]); w.y = pk2(x[j][2], x[j][3]); st8_wt((bf16_t*)xdst + (size_t)row * D + 4 * F.lane + 256 * j, w); }
            } else {
#pragma unroll
                for (int j = 0; j < 8; ++j) st16_wt((float*)xdst + (size_t)row * D + 4 * F.lane + 256 * j, x[j]); } }
        if (has_pre) {
            float ss = 0.f;
#pragma unroll
            for (int j = 0; j < 8; ++j) ss += (x[j][0] * x[j][0] + x[j][1] * x[j][1]) + (x[j][2] * x[j][2] + x[j][3] * x[j][3]);
            const float rx = rsqrtf(wave_sum(ss) * (1.0f / D) + EPS);
            const float* sh = MOD + (size_t)((l_pre * 3 + set) * NMOD + 3 * j_pre) * D; const float* scl = sh + D; const float* gp = ng + (size_t)(l_pre * 6 + 2 * j_pre) * D;
#pragma unroll
            for (int j = 0; j < 8; ++j) { const f32x4 s0 = *(const f32x4*)(sh + 4 * F.lane + 256 * j), s1 = *(const f32x4*)(scl + 4 * F.lane + 256 * j), gg = *(const f32x4*)(gp + 4 * F.lane + 256 * j);
                const f32x4 h = ((x[j] * rx) * gg) * (1.0f + s1) + s0;
                u32x2 w; w.x = pk2(h[0], h[1]); w.y = pk2(h[2], h[3]);
                st8_wt(Hb + (size_t)row * D + 4 * F.lane + 256 * j, w); }
        }
    }
}

struct S5Par { f32x2 a; f32x2 b[16]; };
__device__ __forceinline__ void s5_load_par(const Frame& F, int e, int dir, int g, S5Par& P, f32x2& a64) {
    const int p = F.lane; const size_t gi = (size_t)((e * 2 + dir) * 64 + g);
    float lr = F.in[I_LAMRE][gi * 64 + p]; lr = fminf(lr, -1e-4f); const float li = F.in[I_LAMIM][gi * 64 + p];
    const float dt = __expf(F.in[I_LOGDT][gi]);
    const float mag = __expf(lr * dt); float tt = li * dt * 0.15915494309189535f; tt -= rintf(tt);
    const float are = mag * __builtin_amdgcn_cosf(tt), aim = mag * __builtin_amdgcn_sinf(tt);
    P.a = (f32x2){are, aim};
    const float nr = are - 1.0f, ni = aim, den = 1.0f / (lr * lr + li * li);
    const float sr = (nr * lr + ni * li) * den, si = (ni * lr - nr * li) * den;
    const float* br = F.in[I_BRE] + (gi * 64 + p) * 16; const float* bi = F.in[I_BIM] + (gi * 64 + p) * 16;
#pragma unroll
    for (int q = 0; q < 4; ++q) { const f32x4 r4 = *(const f32x4*)(br + 4 * q), i4 = *(const f32x4*)(bi + 4 * q);
#pragma unroll
        for (int j = 0; j < 4; ++j) P.b[4 * q + j] = (f32x2){sr * r4[j] - si * i4[j], sr * i4[j] + si * r4[j]}; }
    float xr = are, xi = aim;
#pragma unroll
    for (int s = 0; s < 6; ++s) { const float t2 = xr * xr - xi * xi; xi = 2.0f * xr * xi; xr = t2; }
    a64 = (f32x2){xr, xi};
}
__device__ __forceinline__ void s5_stage_u(const Frame& F, int sp, int g, LAS float* ub) {
    const bf16_t* src = (const bf16_t*)(F.ws + WS_PROJ) + (size_t)(sp * 64 + F.lane) * EVEN_IN + g * 16;
    const u32x4 w0 = *(const u32x4*)src, w1 = *(const u32x4*)(src + 8);
    LAS f32x4* d = (LAS f32x4*)(ub + F.lane * 16);
    d[0] = (f32x4){bflo(w0.x), bfhi(w0.x), bflo(w0.y), bfhi(w0.y)}; d[1] = (f32x4){bflo(w0.z), bfhi(w0.z), bflo(w0.w), bfhi(w0.w)};
    d[2] = (f32x4){bflo(w1.x), bfhi(w1.x), bflo(w1.y), bfhi(w1.y)}; d[3] = (f32x4){bflo(w1.z), bfhi(w1.z), bflo(w1.w), bfhi(w1.w)};
    LDS_WAIT();
}
__device__ __forceinline__ void s5_bu4(const S5Par& P, const LAS float* ub0, int stepf, f32x2 (&bu)[4]) {
    f32x4 u[4][4];
#pragma unroll
    for (int q = 0; q < 4; ++q) { const LAS f32x4* up = (const LAS f32x4*)(ub0 + q * stepf); u[q][0] = up[0]; u[q][1] = up[1]; u[q][2] = up[2]; u[q][3] = up[3]; }
#pragma unroll
    for (int q = 0; q < 4; ++q) {
        f32x2 s0 = P.b[0] * u[q][0][0], s1 = P.b[1] * u[q][0][1], s2 = P.b[2] * u[q][0][2], s3 = P.b[3] * u[q][0][3];
        s0 += P.b[4] * u[q][1][0]; s1 += P.b[5] * u[q][1][1]; s2 += P.b[6] * u[q][1][2]; s3 += P.b[7] * u[q][1][3];
        s0 += P.b[8] * u[q][2][0]; s1 += P.b[9] * u[q][2][1]; s2 += P.b[10] * u[q][2][2]; s3 += P.b[11] * u[q][2][3];
        s0 += P.b[12] * u[q][3][0]; s1 += P.b[13] * u[q][3][1]; s2 += P.b[14] * u[q][3][2]; s3 += P.b[15] * u[q][3][3];
        bu[q] = (s0 + s1) + (s2 + s3);
    }
}
__device__ __forceinline__ f32x2 s5_adv(const f32x2 are2, const f32x2 aim2, const f32x2 h, const f32x2 b) { return are2 * h + (aim2 * (f32x2){h.y, h.x} + b); }
__device__ __forceinline__ void s5_pass1(const Frame& F0, int e) {
    const Frame F = refresh(F0);
    LAS float* ub = (LAS float*)(F.lds + F.wave * 4096);
    float* SST = (float*)(F.ws + WS_SST);
    for (int unit = F.gw; unit < 96 * 64; unit += F.NGW) {
        const int sp = unit >> 6, g = unit & 63;
        s5_stage_u(F, sp, g, ub);
#pragma unroll
        for (int dir = 0; dir < 2; ++dir) {
            S5Par P; f32x2 a64; s5_load_par(F, e, dir, g, P, a64);
            const f32x2 are2 = {P.a.x, P.a.x}, aim2 = {-P.a.y, P.a.y};
            f32x2 h = {0.f, 0.f};
#pragma unroll 1
            for (int ch = 0; ch < 16; ++ch) {
                f32x2 bu[4]; s5_bu4(P, dir == 0 ? ub + ch * 64 : ub + (63 - ch * 4) * 16, dir == 0 ? 16 : -16, bu);
#pragma unroll
                for (int q = 0; q < 4; ++q) h = s5_adv(are2, aim2, h, bu[q]); }
            float* o = SST + ((size_t)(sp * 64 + g) * 2 + dir) * 128;
            o[F.lane] = h.x; o[64 + F.lane] = h.y;
        }
        LDS_WAIT();
    }
}
__device__ __forceinline__ float gelu_tanh(float y) { const float x = 0.7978845608028654f * (y + 0.044715f * y * y * y); const float t = 1.0f - 2.0f * __builtin_amdgcn_rcpf(1.0f + __expf(2.0f * x)); return 0.5f * y * (1.0f + t); }
__device__ __forceinline__ void s5_pass2(const Frame& F0, int e) {
    const Frame F = refresh(F0);
    LAS float* ub = (LAS float*)(F.lds + F.wave * 4096);
    LAS unsigned char* hb = F.lds + 32768 + F.wave * 8704;
    const float* SST = (const float*)(F.ws + WS_SST);
    bf16_t* Zb = (bf16_t*)(F.ws + WS_Z);
    for (int unit = F.gw; unit < 96 * 64; unit += F.NGW) {
        int lane_ = F.lane; asm volatile("" : "+v"(lane_));
        const int lane = lane_, fr = lane & 15, fq = lane >> 4;
        const int sp = unit >> 6, g = unit & 63;
        const bool isctx = sp < 64; const int seq_sp0 = isctx ? (sp & ~3) : 64 + ((sp - 64) & ~15), seq_nsp = isctx ? 4 : 16;
        const int nseq = isctx ? (sp >> 2) : ((sp - 64) >> 4);
        s5_stage_u(F, sp, g, ub);
        f32x4 acc[4];
#pragma unroll
        for (int i = 0; i < 4; ++i) acc[i] = (f32x4){0.f, 0.f, 0.f, 0.f};
#pragma unroll
        for (int dir = 0; dir < 2; ++dir) {
            const int nprev = dir == 0 ? sp - seq_sp0 : seq_sp0 + seq_nsp - 1 - sp;
            f32x2 sv[15];
#pragma unroll
            for (int q = 0; q < 15; ++q) { const int qq = q < nprev ? q : 0; const int ss = dir == 0 ? seq_sp0 + qq : seq_sp0 + seq_nsp - 1 - qq;
                const float* sp_ = SST + ((size_t)(ss * 64 + g) * 2 + dir) * 128; sv[q] = (f32x2){sp_[lane], sp_[64 + lane]}; }
            const size_t si = (size_t)((((nseq & 1) * 2 + e) * 2 + dir) * 64 + g) * 64 + lane;
            f32x2 h = {F.in[I_S5RE][si], F.in[I_S5IM][si]};
            const size_t gi = (size_t)((e * 2 + dir) * 64 + g);
            const float* cr = F.in[I_CRE] + (gi * 16 + fr) * 64 + 4 * fq; const float* ci = F.in[I_CIM] + (gi * 16 + fr) * 64 + 4 * fq;
            bf16x8 cf[4];
#pragma unroll
            for (int ks = 0; ks < 4; ++ks) { const f32x4 crv = *(const f32x4*)(cr + 16 * ks), civ = *(const f32x4*)(ci + 16 * ks);
                u32x4 w; w.x = pk2(crv[0], -civ[0]); w.y = pk2(crv[1], -civ[1]); w.z = pk2(crv[2], -civ[2]); w.w = pk2(crv[3], -civ[3]); cf[ks] = __builtin_bit_cast(bf16x8, w); }
            S5Par P; f32x2 a64; s5_load_par(F, e, dir, g, P, a64);
            if (isctx) h = (f32x2){0.f, 0.f};
            { const f32x2 r2 = {a64.x, a64.x}, i2 = {-a64.y, a64.y};
#pragma unroll
              for (int q = 0; q < 15; ++q) { const f32x2 hn = s5_adv(r2, i2, h, sv[q]); h = q < nprev ? hn : h; } }
            const f32x2 are2 = {P.a.x, P.a.x}, aim2 = {-P.a.y, P.a.y};
#pragma unroll
            for (int sbi = 0; sbi < 2; ++sbi) {
                const int sb = dir == 0 ? sbi : 1 - sbi;
#pragma unroll 1
                for (int ch = 0; ch < 8; ++ch) {
                    const int t0 = dir == 0 ? ch * 4 : 31 - ch * 4;
                    f32x2 bu[4]; s5_bu4(P, ub + (sb * 32 + t0) * 16, dir == 0 ? 16 : -16, bu);
#pragma unroll
                    for (int q = 0; q < 4; ++q) { const int t = dir == 0 ? t0 + q : t0 - q;
                        h = s5_adv(are2, aim2, h, bu[q]);
                        *(LAS unsigned*)(hb + t * 272 + lane * 4) = pk2(h.x, h.y); } }
                LDS_WAIT();
#pragma unroll
                for (int mt = 0; mt < 2; ++mt)
#pragma unroll
                    for (int ks = 0; ks < 4; ++ks) { const bf16x8 af = *(const LAS bf16x8*)(hb + (mt * 16 + fr) * 272 + (8 * fq + 32 * ks) * 2);
                        acc[sb * 2 + mt] = __builtin_amdgcn_mfma_f32_16x16x32_bf16(af, cf[ks], acc[sb * 2 + mt], 0, 0, 0); }
                LDS_WAIT();
            }
            if (isctx && ((dir == 0 && sp == seq_sp0 + 3) || (dir == 1 && sp == seq_sp0))) {
                const size_t oi = (size_t)(((nseq * 2 + e) * 2 + dir) * 64 + g) * 64 + lane;
                F.out[OUT_S5RE + oi] = DBG_SCALE * h.x; F.out[OUT_S5IM + oi] = DBG_SCALE * h.y; }
        }
        const float dsk = F.in[I_S5D][e * 1024 + g * 16 + fr];
#pragma unroll
        for (int tile = 0; tile < 4; ++tile)
#pragma unroll
            for (int r = 0; r < 4; ++r) { const int t = 16 * tile + 4 * fq + r; const float y = acc[tile][r] + dsk * ub[t * 16 + fr];
                *(LAS bf16_t*)(hb + t * 32 + fr * 2) = (bf16_t)f2bf(gelu_tanh(y)); }
        LDS_WAIT();
        { const u32x4 z0 = *(const LAS u32x4*)(hb + lane * 32), z1 = *(const LAS u32x4*)(hb + lane * 32 + 16);
          bf16_t* zp = Zb + (size_t)(sp * 64 + lane) * 1024 + g * 16; st16_wt(zp, z0); st16_wt(zp + 8, z1); }
        LDS_WAIT();
    }
}

constexpr int KS_PITCH = 272, VT_PITCH = 264;
constexpr int ENG_KS = 0, ENG_VT = 128 * KS_PITCH;

__device__ __forceinline__ void stage_k_bf16(LAS unsigned char* Ks, const bf16_t* src, int ld, int tid) {
    const int key = tid >> 2, part = tid & 3;
    const u32x4* s = (const u32x4*)(src + (size_t)key * ld + part * 32);
    const u32x4 a = s[0], b = s[1], c = s[2], d = s[3];
    LAS u32x4* dst = (LAS u32x4*)(Ks + key * KS_PITCH + part * 64);
    dst[0] = a; dst[1] = b; dst[2] = c; dst[3] = d;
}
__device__ __forceinline__ void stage_k_f32(LAS unsigned char* Ks, const float* src, int ld, int tid) {
    const int key = tid >> 2, part = tid & 3;
    const f32x4* s = (const f32x4*)(src + (size_t)key * ld + part * 32);
    LAS u32x4* dst = (LAS u32x4*)(Ks + key * KS_PITCH + part * 64);
#pragma unroll
    for (int q = 0; q < 4; ++q) { const f32x4 a = s[2 * q], b = s[2 * q + 1]; u32x4 w; w.x = pk2(a[0], a[1]); w.y = pk2(a[2], a[3]); w.z = pk2(b[0], b[1]); w.w = pk2(b[2], b[3]); dst[q] = w; }
}
__device__ __forceinline__ void unpack8(const u32x4 w, float* x) { x[0] = bflo(w.x); x[1] = bfhi(w.x); x[2] = bflo(w.y); x[3] = bfhi(w.y); x[4] = bflo(w.z); x[5] = bfhi(w.z); x[6] = bflo(w.w); x[7] = bfhi(w.w); }
__device__ __forceinline__ u32x4 pack8(const float* x) { u32x4 w; w.x = pk2(x[0], x[1]); w.y = pk2(x[2], x[3]); w.z = pk2(x[4], x[5]); w.w = pk2(x[6], x[7]); return w; }
__device__ __forceinline__ void stage_k_rope(LAS unsigned char* Ks, const bf16_t* src, int ld, int t0, const float* rope, int tid) {
    const int key = tid >> 2, part = tid & 3, half = part >> 1, sub = part & 1, t = t0 + key, pos = half ? (t & 63) : (t >> 6);
    const bf16_t* p1 = src + (size_t)key * ld + 64 * half + 16 * sub;
    const u32x4 a0 = *(const u32x4*)p1, a1 = *(const u32x4*)(p1 + 8), b0 = *(const u32x4*)(p1 + 32), b1 = *(const u32x4*)(p1 + 40);
    float x1[16], x2[16], o1[16], o2[16];
    unpack8(a0, x1); unpack8(a1, x1 + 8); unpack8(b0, x2); unpack8(b1, x2 + 8);
    const float* cs = rope + pos * 32 + 16 * sub; const float* sn = cs + 2048;
#pragma unroll
    for (int q = 0; q < 4; ++q) { const f32x4 c4 = *(const f32x4*)(cs + 4 * q), s4 = *(const f32x4*)(sn + 4 * q);
#pragma unroll
        for (int j = 0; j < 4; ++j) { const int i = 4 * q + j; o1[i] = x1[i] * c4[j] - x2[i] * s4[j]; o2[i] = x1[i] * s4[j] + x2[i] * c4[j]; } }
    LAS u32x4* d1 = (LAS u32x4*)(Ks + key * KS_PITCH + (64 * half + 16 * sub) * 2);
    d1[0] = pack8(o1); d1[1] = pack8(o1 + 8); d1[4] = pack8(o2); d1[5] = pack8(o2 + 8);
}
template <bool WEIGHTED>
__device__ __forceinline__ void stage_vt_bf16(LAS unsigned char* Vt, const bf16_t* src, int ld, int tid, float wgt) {
    const int key = tid >> 2, part = tid & 3;
    const u32x4* s = (const u32x4*)(src + (size_t)key * ld + part * 32);
    const u32x4 a = s[0], b = s[1], c = s[2], d = s[3];
    const unsigned w[16] = {a.x, a.y, a.z, a.w, b.x, b.y, b.z, b.w, c.x, c.y, c.z, c.w, d.x, d.y, d.z, d.w};
    LAS unsigned char* dst = Vt + (part * 32) * VT_PITCH + key * 2;
#pragma unroll
    for (int q = 0; q < 16; ++q) {
        if (WEIGHTED) { *(LAS bf16_t*)(dst + (2 * q) * VT_PITCH) = (bf16_t)f2bf(bflo(w[q]) * wgt); *(LAS bf16_t*)(dst + (2 * q + 1) * VT_PITCH) = (bf16_t)f2bf(bfhi(w[q]) * wgt); }
        else { *(LAS bf16_t*)(dst + (2 * q) * VT_PITCH) = (bf16_t)(w[q] & 0xffffu); *(LAS bf16_t*)(dst + (2 * q + 1) * VT_PITCH) = (bf16_t)(w[q] >> 16); } }
}
__device__ __forceinline__ void stage_vt_f32(LAS unsigned char* Vt, const float* src, int ld, int tid) {
    const int key = tid >> 2, part = tid & 3;
    const f32x4* s = (const f32x4*)(src + (size_t)key * ld + part * 32);
    LAS unsigned char* dst = Vt + (part * 32) * VT_PITCH + key * 2;
#pragma unroll
    for (int q = 0; q < 8; ++q) { const f32x4 a = s[q];
#pragma unroll
        for (int j = 0; j < 4; ++j) *(LAS bf16_t*)(dst + (4 * q + j) * VT_PITCH) = (bf16_t)f2bf(a[j]); }
}
__device__ __forceinline__ void qk_tiles(const LAS unsigned char* Ks, int sb, int fr, int fq, const bf16x8 (&qf)[4], f32x4 (&st)[2]) {
#pragma unroll
    for (int tt = 0; tt < 2; ++tt) { st[tt] = (f32x4){0.f, 0.f, 0.f, 0.f};
#pragma unroll
        for (int ks = 0; ks < 4; ++ks) { const bf16x8 kf = *(const LAS bf16x8*)(Ks + (32 * sb + 16 * tt + fr) * KS_PITCH + (8 * fq + 32 * ks) * 2);
            st[tt] = __builtin_amdgcn_mfma_f32_16x16x32_bf16(kf, qf[ks], st[tt], 0, 0, 0); } }
}
__device__ __forceinline__ void pv_step(const LAS unsigned char* Vt, int sb, int fr, int fq, const bf16x8 pf, f32x4 (&o)[8]) {
#pragma unroll
    for (int dt = 0; dt < 8; ++dt) { const LAS unsigned char* vp = Vt + (16 * dt + fr) * VT_PITCH + (32 * sb + 4 * fq) * 2;
        const u32x2 lo = *(const LAS u32x2*)vp, hi = *(const LAS u32x2*)(vp + 32);
        u32x4 w; w.x = lo.x; w.y = lo.y; w.z = hi.x; w.w = hi.y;
        o[dt] = __builtin_amdgcn_mfma_f32_16x16x32_bf16(__builtin_bit_cast(bf16x8, w), pf, o[dt], 0, 0, 0); }
}
__device__ __forceinline__ bf16x8 pack_p(const f32x4 p0, const f32x4 p1) { u32x4 w; w.x = pk2(p0[0], p0[1]); w.y = pk2(p0[2], p0[3]); w.z = pk2(p1[0], p1[1]); w.w = pk2(p1[2], p1[3]); return __builtin_bit_cast(bf16x8, w); }
__device__ __forceinline__ void load_q(const bf16_t* qrow, int fq, bf16x8 (&qf)[4]) {
#pragma unroll
    for (int ks = 0; ks < 4; ++ks) qf[ks] = __builtin_bit_cast(bf16x8, *(const u32x4*)(qrow + 8 * fq + 32 * ks));
}
__device__ __forceinline__ void rope_q(bf16x8 (&qf)[4], int t, int fq, const float* rope) {
#pragma unroll
    for (int half = 0; half < 2; ++half) { const int pos = half ? (t & 63) : (t >> 6);
        float x1[8], x2[8], o1[8], o2[8]; unpack8(__builtin_bit_cast(u32x4, qf[2 * half]), x1); unpack8(__builtin_bit_cast(u32x4, qf[2 * half + 1]), x2);
        const float* cs = rope + pos * 32 + 8 * fq; const float* sn = cs + 2048;
        const f32x4 c0 = *(const f32x4*)cs, c1 = *(const f32x4*)(cs + 4), s0 = *(const f32x4*)sn, s1 = *(const f32x4*)(sn + 4);
#pragma unroll
        for (int j = 0; j < 4; ++j) { o1[j] = x1[j] * c0[j] - x2[j] * s0[j]; o2[j] = x1[j] * s0[j] + x2[j] * c0[j]; o1[4 + j] = x1[4 + j] * c1[j] - x2[4 + j] * s1[j]; o2[4 + j] = x1[4 + j] * s1[j] + x2[4 + j] * c1[j]; }
        qf[2 * half] = __builtin_bit_cast(bf16x8, pack8(o1)); qf[2 * half + 1] = __builtin_bit_cast(bf16x8, pack8(o2)); }
}

struct ChunkRegs { u32x4 k[4], v[4]; };
__device__ __forceinline__ void chunk_load(ChunkRegs& R, const bf16_t* ksrc, const bf16_t* vsrc, int ld, int tid) {
    const int key = tid >> 2, part = tid & 3;
    const GAS u32x4* ks = (const GAS u32x4*)((const GAS bf16_t*)ksrc + (size_t)key * ld + part * 32); const GAS u32x4* vs = (const GAS u32x4*)((const GAS bf16_t*)vsrc + (size_t)key * ld + part * 32);
#pragma unroll
    for (int q = 0; q < 4; ++q) { R.k[q] = ks[q]; R.v[q] = vs[q]; }
}
__device__ __forceinline__ void chunk_write(const ChunkRegs& R, LAS unsigned char* Ks, LAS unsigned char* Vt, int tid) {
    const int key = tid >> 2, part = tid & 3;
    LAS u32x4* kd = (LAS u32x4*)(Ks + key * KS_PITCH + part * 64);
#pragma unroll
    for (int q = 0; q < 4; ++q) kd[q] = R.k[q];
    const unsigned w[16] = {R.v[0].x, R.v[0].y, R.v[0].z, R.v[0].w, R.v[1].x, R.v[1].y, R.v[1].z, R.v[1].w, R.v[2].x, R.v[2].y, R.v[2].z, R.v[2].w, R.v[3].x, R.v[3].y, R.v[3].z, R.v[3].w};
    LAS unsigned char* dst = Vt + (part * 32) * VT_PITCH + key * 2;
#pragma unroll
    for (int q = 0; q < 16; ++q) { *(LAS bf16_t*)(dst + (2 * q) * VT_PITCH) = (bf16_t)(w[q] & 0xffffu); *(LAS bf16_t*)(dst + (2 * q + 1) * VT_PITCH) = (bf16_t)(w[q] >> 16); }
}
__device__ __forceinline__ float log_sigmoid_big(float x) { const float y = __expf(-x); return -(y * (1.0f + y * (-0.5f + y * (0.33333334f + y * (-0.25f + y * 0.2f))))); }
__device__ __forceinline__ void ret_unit(const Frame& F, int e, bool isctx, int n, int h, int qb) {
    LAS unsigned char* Ks = F.lds + ENG_KS; LAS unsigned char* Vt = F.lds + ENG_VT;
    const bf16_t* PROJ = (const bf16_t*)(F.ws + WS_PROJ);
    const int lane = F.lane, fr = lane & 15, fq = lane >> 4;
    const int R0 = isctx ? 256 * n : NCTX + 1024 * n, L = isctx ? 256 : 1024, nkc = L >> 7;
    const int iq = 128 * qb + 16 * F.wave + fr;
    const float lgf = log_sigmoid_big(F.in[I_DECAY][(e * 2 + 0) * 8 + h]), lgb = log_sigmoid_big(F.in[I_DECAY][(e * 2 + 1) * 8 + h]);
    const float kscale = 0.08838834764831845f;
    bf16x8 qf[4]; load_q(PROJ + (size_t)(R0 + iq) * EVEN_IN + 1024 + 128 * h, fq, qf);
    f32x4 o[8];
#pragma unroll
    for (int dt = 0; dt < 8; ++dt) o[dt] = (f32x4){0.f, 0.f, 0.f, 0.f};
    ChunkRegs CR; chunk_load(CR, PROJ + (size_t)R0 * EVEN_IN + 2048 + 128 * h, PROJ + (size_t)R0 * EVEN_IN + 3072 + 128 * h, EVEN_IN, F.tid);
    for (int kc = 0; kc < nkc; ++kc) {
        __syncthreads();
        chunk_write(CR, Ks, Vt, F.tid);
        __syncthreads();
        if (kc + 1 < nkc) chunk_load(CR, PROJ + (size_t)(R0 + 128 * (kc + 1)) * EVEN_IN + 2048 + 128 * h, PROJ + (size_t)(R0 + 128 * (kc + 1)) * EVEN_IN + 3072 + 128 * h, EVEN_IN, F.tid);
#pragma unroll 1
        for (int sb = 0; sb < 4; ++sb) {
            f32x4 st[2]; qk_tiles(Ks, sb, fr, fq, qf, st);
#pragma unroll
            for (int tt = 0; tt < 2; ++tt)
#pragma unroll
                for (int r = 0; r < 4; ++r) { const int j = 128 * kc + 32 * sb + 16 * tt + 4 * fq + r; const int df = iq - j;
                    const float m = df > 0 ? __expf((float)df * lgf) : (df < 0 ? __expf((float)(-df) * lgb) : 2.0f);
                    st[tt][r] *= kscale * m; }
            pv_step(Vt, sb, fr, fq, pack_p(st[0], st[1]), o);
        }
    }
    if (!isctx) {
        const bf16_t* qrow = PROJ + (size_t)(R0 + iq) * EVEN_IN + 1024 + 128 * h;
#pragma unroll 1
        for (int dir = 0; dir < 2; ++dir) {
            __syncthreads();
            stage_vt_f32(Vt, F.in[I_SRET] + (size_t)(((n * 2 + e) * 2 + dir) * 8 + h) * 16384, 128, F.tid);
            __syncthreads();
            const float wq = dir == 0 ? __expf((float)(iq + 1) * lgf) : __expf((float)(L - iq) * lgb);
#pragma unroll 1
            for (int sb = 0; sb < 4; ++sb) {
                const u32x2 lo = *(const u32x2*)(qrow + 32 * sb + 4 * fq), hi = *(const u32x2*)(qrow + 32 * sb + 16 + 4 * fq);
                f32x4 p0 = {bflo(lo.x) * wq, bfhi(lo.x) * wq, bflo(lo.y) * wq, bfhi(lo.y) * wq}, p1 = {bflo(hi.x) * wq, bfhi(hi.x) * wq, bflo(hi.y) * wq, bfhi(hi.y) * wq};
                pv_step(Vt, sb, fr, fq, pack_p(p0, p1), o);
            }
        }
    }
    float s = 0.f;
#pragma unroll
    for (int dt = 0; dt < 8; ++dt) s += (o[dt][0] + o[dt][1]) + (o[dt][2] + o[dt][3]);
    s += __shfl_xor(s, 16); s += __shfl_xor(s, 32);
    const float mu = s * (1.0f / 128.0f); float v = 0.f;
#pragma unroll
    for (int dt = 0; dt < 8; ++dt) { const f32x4 d = o[dt] - mu; v += (d[0] * d[0] + d[1] * d[1]) + (d[2] * d[2] + d[3] * d[3]); }
    v += __shfl_xor(v, 16); v += __shfl_xor(v, 32);
    const float rs = rsqrtf(v * (1.0f / 128.0f) + EPS);
    const bf16_t* grow = PROJ + (size_t)(R0 + iq) * EVEN_IN + 4096 + 128 * h; bf16_t* yrow = (bf16_t*)(F.ws + WS_YCAT) + (size_t)(R0 + iq) * 2048 + 1024 + 128 * h;
    const float* gn = F.in[I_GNG] + e * 1024 + 128 * h;
#pragma unroll
    for (int dt = 0; dt < 8; ++dt) { const int ee = 16 * dt + 4 * fq; const u32x2 gw = *(const u32x2*)(grow + ee); const f32x4 g4 = *(const f32x4*)(gn + ee);
        const float g0 = bflo(gw.x), g1 = bfhi(gw.x), g2 = bflo(gw.y), g3 = bfhi(gw.y);
        u32x2 w; w.x = pk2(siluf_(g0) * ((o[dt][0] - mu) * rs * g4[0]), siluf_(g1) * ((o[dt][1] - mu) * rs * g4[1]));
        w.y = pk2(siluf_(g2) * ((o[dt][2] - mu) * rs * g4[2]), siluf_(g3) * ((o[dt][3] - mu) * rs * g4[3]));
        st8_wt(yrow + ee, w); }
}
__device__ __forceinline__ void ret_final_unit(const Frame& F, int e, int n, int h, int dir) {
    LAS unsigned char* Kt = F.lds + ENG_KS; LAS unsigned char* Vt = F.lds + ENG_VT;
    const bf16_t* PROJ = (const bf16_t*)(F.ws + WS_PROJ);
    const int lane = F.lane, fr = lane & 15, fq = lane >> 4, R0 = 256 * n;
    const float lg = log_sigmoid_big(F.in[I_DECAY][(e * 2 + dir) * 8 + h]);
    f32x4 acc[8];
#pragma unroll
    for (int et = 0; et < 8; ++et) acc[et] = (f32x4){0.f, 0.f, 0.f, 0.f};
    for (int kc = 0; kc < 2; ++kc) {
        __syncthreads();
        { const int j = 128 * kc + (F.tid >> 2); const float wj = 0.08838834764831845f * (dir == 0 ? __expf((float)(255 - j) * lg) : __expf((float)j * lg));
          stage_vt_bf16<true>(Kt, PROJ + (size_t)(R0 + 128 * kc) * EVEN_IN + 2048 + 128 * h, EVEN_IN, F.tid, wj); }
        stage_vt_bf16<false>(Vt, PROJ + (size_t)(R0 + 128 * kc) * EVEN_IN + 3072 + 128 * h, EVEN_IN, F.tid, 1.0f);
        __syncthreads();
#pragma unroll
        for (int ks = 0; ks < 4; ++ks) {
            const LAS unsigned char* kp = Kt + (16 * F.wave + fr) * VT_PITCH + (32 * ks + 8 * fq) * 2;
            const u32x2 k0 = *(const LAS u32x2*)kp, k1 = *(const LAS u32x2*)(kp + 8); u32x4 kw; kw.x = k0.x; kw.y = k0.y; kw.z = k1.x; kw.w = k1.y;
#pragma unroll
            for (int et = 0; et < 8; ++et) { const LAS unsigned char* vp = Vt + (16 * et + fr) * VT_PITCH + (32 * ks + 8 * fq) * 2;
                const u32x2 v0 = *(const LAS u32x2*)vp, v1 = *(const LAS u32x2*)(vp + 8); u32x4 vw; vw.x = v0.x; vw.y = v0.y; vw.z = v1.x; vw.w = v1.y;
                acc[et] = __builtin_amdgcn_mfma_f32_16x16x32_bf16(__builtin_bit_cast(bf16x8, kw), __builtin_bit_cast(bf16x8, vw), acc[et], 0, 0, 0); }
        }
    }
    float* outp = F.out + OUT_RET + (size_t)(((n * 2 + e) * 2 + dir) * 8 + h) * 16384;
#pragma unroll
    for (int et = 0; et < 8; ++et)
#pragma unroll
        for (int r = 0; r < 4; ++r) outp[(size_t)(16 * F.wave + 4 * fq + r) * 128 + 16 * et + fr] = DBG_SCALE * acc[et][r];
}
__device__ __forceinline__ void retention_phase(const Frame& F0, int e) {
    const Frame F = refresh(F0);
    const int b = blockIdx.x;
    { int first, cnt, step; if (F.G == 256) { first = b < 128 ? b : 128 + 2 * (b - 128); cnt = b < 128 ? 1 : 2; step = 1; } else { first = b; cnt = (384 - b + F.G - 1) / F.G; step = F.G; }
#pragma unroll 1
      for (int k = 0; k < cnt; ++k) { const int u = first + k * step; const bool isctx = u >= 128; const int c = u - 128;
          ret_unit(F, e, isctx, isctx ? c >> 4 : u >> 6, isctx ? (c >> 1) & 7 : (u >> 3) & 7, isctx ? c & 1 : u & 7); } }
    for (int u = b; u < 256; u += F.G) ret_final_unit(F, e, u >> 4, (u >> 1) & 7, u & 1);
    __syncthreads();
}

template <bool MASKED>
__device__ __forceinline__ void softmax_block(f32x4 (&st)[2], int iq, int j0  , int fq, float& m, float& l, f32x4 (&o)[8]) {
    const float scale = 0.08838834764831845f;
    float mx = -3.0e38f;
#pragma unroll
    for (int tt = 0; tt < 2; ++tt)
#pragma unroll
        for (int r = 0; r < 4; ++r) { float sv = st[tt][r] * scale;
            if (MASKED) { const int j = j0 + 16 * tt + 4 * fq + r; const int df = j - iq; if (df > 128 || df < -128) sv = -3.0e38f; }
            st[tt][r] = sv; mx = fmaxf(mx, sv); }
    mx = fmaxf(mx, __shfl_xor(mx, 16)); mx = fmaxf(mx, __shfl_xor(mx, 32));
    const float mn = fmaxf(m, mx), alpha = __expf(m - mn);
    float ps = 0.f;
#pragma unroll
    for (int tt = 0; tt < 2; ++tt)
#pragma unroll
        for (int r = 0; r < 4; ++r) { const float p = st[tt][r] > -1.0e38f ? __expf(st[tt][r] - mn) : 0.f; st[tt][r] = p; ps += p; }
    l = l * alpha + ps; m = mn;
#pragma unroll
    for (int dt = 0; dt < 8; ++dt) o[dt] *= alpha;
}
__device__ __forceinline__ void attn_unit(const Frame& F, int oi, bool isctx, int n, int hq, int qb) {
    LAS unsigned char* Ks = F.lds + ENG_KS; LAS unsigned char* Vt = F.lds + ENG_VT;
    const bf16_t* PROJ = (const bf16_t*)(F.ws + WS_PROJ); const float* rope = (const float*)(F.ws + WS_ROPE);
    const int lane = F.lane, fr = lane & 15, fq = lane >> 4, hkv = hq >> 2;
    const int R0 = isctx ? 256 * n : NCTX + 1024 * n;
    const int iq = 128 * qb + 16 * F.wave + fr, iq0 = 128 * qb + 16 * F.wave;
    bf16x8 qf[4]; load_q(PROJ + (size_t)(R0 + iq) * ODD_IN + 1024 + 128 * hq, fq, qf);
    if (!isctx) rope_q(qf, iq, fq, rope);
    f32x4 o[8];
#pragma unroll
    for (int dt = 0; dt < 8; ++dt) o[dt] = (f32x4){0.f, 0.f, 0.f, 0.f};
    float m = F.in[I_SINK][oi * 8 + hq], l = fq == 0 ? 1.0f : 0.0f;
    if (isctx) {
        for (int kc = 0; kc < 2; ++kc) {
            __syncthreads();
            stage_k_bf16(Ks, PROJ + (size_t)(R0 + 128 * kc) * ODD_IN + 2048 + 128 * hkv, ODD_IN, F.tid);
            stage_vt_bf16<false>(Vt, PROJ + (size_t)(R0 + 128 * kc) * ODD_IN + 2304 + 128 * hkv, ODD_IN, F.tid, 1.0f);
            __syncthreads();
#pragma unroll 1
            for (int sb = 0; sb < 4; ++sb) { f32x4 st[2]; qk_tiles(Ks, sb, fr, fq, qf, st); softmax_block<false>(st, iq, 0, fq, m, l, o); pv_step(Vt, sb, fr, fq, pack_p(st[0], st[1]), o); }
        }
    } else {
        for (int kc = qb - 1; kc <= qb + 1; ++kc) {
            if (kc < 0 || kc >= 8) continue;
            __syncthreads();
            stage_k_rope(Ks, PROJ + (size_t)(R0 + 128 * kc) * ODD_IN + 2048 + 128 * hkv, ODD_IN, 128 * kc, rope, F.tid);
            stage_vt_bf16<false>(Vt, PROJ + (size_t)(R0 + 128 * kc) * ODD_IN + 2304 + 128 * hkv, ODD_IN, F.tid, 1.0f);
            __syncthreads();
#pragma unroll 1
            for (int sb = 0; sb < 4; ++sb) { const int j0 = 128 * kc + 32 * sb;
                if (j0 > iq0 + 15 + 128 || j0 + 31 < iq0 - 128) continue;
                f32x4 st[2]; qk_tiles(Ks, sb, fr, fq, qf, st); softmax_block<true>(st, iq, j0, fq, m, l, o); pv_step(Vt, sb, fr, fq, pack_p(st[0], st[1]), o); }
        }
        for (int kc = 0; kc < 2; ++kc) {
            __syncthreads();
            stage_k_f32(Ks, F.in[I_CK] + ((size_t)((n * 2 + oi) * 256 + 128 * kc) * 2 + hkv) * 128, 256, F.tid);
            stage_vt_f32(Vt, F.in[I_CV] + ((size_t)((n * 2 + oi) * 256 + 128 * kc) * 2 + hkv) * 128, 256, F.tid);
            __syncthreads();
#pragma unroll 1
            for (int sb = 0; sb < 4; ++sb) { f32x4 st[2]; qk_tiles(Ks, sb, fr, fq, qf, st); softmax_block<false>(st, iq, 0, fq, m, l, o); pv_step(Vt, sb, fr, fq, pack_p(st[0], st[1]), o); }
        }
    }
    l += __shfl_xor(l, 16); l += __shfl_xor(l, 32);
    const float inv = __builtin_amdgcn_rcpf(l);
    bf16_t* yrow = (bf16_t*)(F.ws + WS_YCAT) + (size_t)(R0 + iq) * 2048 + 1024 + 128 * hq;
#pragma unroll
    for (int dt = 0; dt < 8; ++dt) { u32x2 w; w.x = pk2(o[dt][0] * inv, o[dt][1] * inv); w.y = pk2(o[dt][2] * inv, o[dt][3] * inv); st8_wt(yrow + 16 * dt + 4 * fq, w); }
}
__device__ __forceinline__ void attention_phase(const Frame& F0, int oi) {
    const Frame F = refresh(F0);
    const int b = blockIdx.x;
    { int first, cnt, step; if (F.G == 256) { first = b < 128 ? b : 128 + 2 * (b - 128); cnt = b < 128 ? 1 : 2; step = 1; } else { first = b; cnt = (384 - b + F.G - 1) / F.G; step = F.G; }
#pragma unroll 1
      for (int k = 0; k < cnt; ++k) { const int u = first + k * step; const bool isctx = u >= 128; const int c = u - 128;
          attn_unit(F, oi, isctx, isctx ? c >> 4 : u >> 6, isctx ? (c >> 1) & 7 : (u >> 3) & 7, isctx ? c & 1 : u & 7); } }
    __syncthreads();
}
__device__ __forceinline__ void pool_phase(const Frame& F0) {
    const Frame F = refresh(F0);
    const bf16_t* PROJ = (const bf16_t*)(F.ws + WS_PROJ); bf16_t* Pb = (bf16_t*)(F.ws + WS_Z);
    const int total = MROWS * 128;
    for (int it = blockIdx.x * 512 + F.tid; it < total; it += F.G * 512) {
        const int row = it >> 7, ch = it & 127, gi = ch >> 5, w = 2 << gi;
        const bool isctx = row < NCTX; const int R0 = isctx ? (row & ~255) : NCTX + ((row - NCTX) & ~1023), L = isctx ? 256 : 1024, t = row - R0;
        int lo = t - (w >> 1), hi = t + (w >> 1) - 1; lo = lo < 0 ? 0 : (lo > L - 1 ? L - 1 : lo); hi = hi < 0 ? 0 : (hi > L - 1 ? L - 1 : hi);
        float s[8] = {0.f, 0.f, 0.f, 0.f, 0.f, 0.f, 0.f, 0.f};
        for (int j = lo; j <= hi; ++j) { float x[8]; unpack8(*(const u32x4*)(PROJ + (size_t)(R0 + j) * ODD_IN + 8 * ch), x);
#pragma unroll
            for (int q = 0; q < 8; ++q) s[q] += x[q]; }
        float x[8]; unpack8(*(const u32x4*)(PROJ + (size_t)row * ODD_IN + 8 * ch), x);
        const float ic = __builtin_amdgcn_rcpf((float)(hi - lo + 1));
#pragma unroll
        for (int q = 0; q < 8; ++q) s[q] = s[q] * ic - x[q];
        st16_wt(Pb + (size_t)row * 1024 + 8 * ch, pack8(s));
    }
}

#ifndef REP_CONV
#define REP_CONV 1
#endif
#ifndef REP_MIX
#define REP_MIX 1
#endif
#ifndef REP_GU
#define REP_GU 1
#endif
#ifndef STOP_L
#define STOP_L 9
#endif
#ifndef STOP_S
#define STOP_S 1
#endif
#define PH_BEGIN int L_ = l; unsigned char* W_ = args.ws; asm volatile("" : "+s"(L_), "+s"(W_)); const int E_ = L_ >> 1; (void)E_;
#define GEMM_RUNX(MB_, Aoff, Boff, M_, N_, K_, lda_, ldb_, apn_, EPI, CID) do { pg8::Gemm g{(const bf16_t*)(W_ + (Aoff)), (const bf16_t*)(W_ + (Boff)), (M_), (N_), (K_), (lda_), (ldb_), (apn_)}; \
    pg8::StaticOrder S; S.init((M_), (N_), (int)gridDim.x, (CID), 64 * (MB_)); pg8::gemm_phase<MB_>((LAS unsigned char*)lds_raw, g, S, EPI, F.wave); } while (0)
#define GEMM_RUNM(MB_, Aoff, Boff, N_, K_, lda_, ldb_, apn_, EPI) GEMM_RUNX(MB_, Aoff, Boff, MROWS, N_, K_, lda_, ldb_, apn_, EPI, (int)blockIdx.x)
constexpr int GU_R1 = 2304, GU_U1 = (GU_R1 / 256) * (2 * FF / 256);
#define GEMM_GU(S_) do { EpiSwiglu E1{(bf16_t*)(W_ + WS_ACT)}; GEMM_RUNX(4, WS_H, ws_wgu(L_, S_), GU_R1, 2 * FF, D, D, D, 0, E1, (int)blockIdx.x); \
    EpiSwiglu E2{(bf16_t*)(W_ + WS_ACT) + (size_t)GU_R1 * FF}; const int G_ = (int)gridDim.x; \
    GEMM_RUNX(3, WS_H + (size_t)GU_R1 * D * 2, ws_wgu(L_, S_), MROWS - GU_R1, 2 * FF, D, D, D, 0, E2, (int)((blockIdx.x + G_ - GU_U1 % G_) % G_)); } while (0)
#define GEMM_RUN(Aoff, Boff, N_, K_, lda_, ldb_, apn_, EPI) GEMM_RUNM(4, Aoff, Boff, N_, K_, lda_, ldb_, apn_, EPI)
#define MIX_EVEN { PH_BEGIN; s5_pass1(F, E_); retention_phase(F, E_); } xcd_barrier(bar, F.wave); { PH_BEGIN; s5_pass2(F, E_); } xcd_barrier(bar, F.wave);
#define MIX_ODD { PH_BEGIN; pool_phase(F); attention_phase(F, E_); } xcd_barrier(bar, F.wave);
#if REP_MIX == 2
#define MIX_EVEN2 MIX_EVEN
#define MIX_ODD2 MIX_ODD
#else
#define MIX_EVEN2
#define MIX_ODD2
#endif
#define LAYER_BODY(LL_) { constexpr int l = LL_; \
        { PH_BEGIN; GEMM_GU(0); } \
        xcd_barrier(bar, F.wave); \
        { PH_BEGIN; EpiBf16<0> E{(bf16_t*)(W_ + WS_Y), D, nullptr, nullptr, 0}; GEMM_RUNM(3, WS_ACT, ws_wd(L_, 0), D, FF, FF, FF, 0, E); } \
        xcd_barrier(bar, F.wave); \
        { PH_BEGIN; bf16_t* Xb = (bf16_t*)(W_ + WS_X); if (l == 0) norm_phase<false, true>(F, true, L_, 0, 0.5f, true, L_, 1, args.in[I_XP], args.in[I_XS], Xb); else norm_phase<true, true>(F, true, L_, 0, 0.5f, true, L_, 1, Xb, Xb + (size_t)NCTX * D, Xb); } \
        xcd_barrier(bar, F.wave); \
        if (l == STOP_L && STOP_S == 0) goto done; \
        if ((l & 1) == 0) { \
            { PH_BEGIN; EpiBf16<0> E{(bf16_t*)(W_ + WS_PROJ), EVEN_IN, nullptr, nullptr, 0}; GEMM_RUN(WS_H, ws_win(L_), EVEN_IN, D, D, D, 0, E); } \
            xcd_barrier(bar, F.wave); \
            if (l == STOP_L && STOP_S == 1) goto done; \
            MIX_EVEN MIX_EVEN2 \
            if (l == STOP_L && STOP_S == 2) goto done; \
            { PH_BEGIN; EpiMix<0> E{(bf16_t*)(W_ + WS_YCAT), (const bf16_t*)(W_ + WS_Z), args.in[I_GLUB] + E_ * 1024}; GEMM_RUN(WS_Z, ws_wx(L_), 1024, 1024, 1024, 1024, 0, E); } \
            xcd_barrier(bar, F.wave); \
        } else { \
            { PH_BEGIN; EpiBf16<1> E{(bf16_t*)(W_ + WS_PROJ), ODD_IN, args.out + OUT_K, args.out + OUT_V, E_}; GEMM_RUN(WS_H, ws_win(L_), ODD_IN, D, D, D, 0, E); } \
            xcd_barrier(bar, F.wave); \
            if (l == STOP_L && STOP_S == 1) goto done; \
            MIX_ODD MIX_ODD2 \
            if (l == STOP_L && STOP_S == 2) goto done; \
            { PH_BEGIN; EpiMix<1> E{(bf16_t*)(W_ + WS_YCAT), nullptr, args.in[I_POOLS] + E_ * 1024}; GEMM_RUN(WS_Z, ws_wx(L_), 1024, 256, 1024, 256, 256, E); } \
            xcd_barrier(bar, F.wave); \
        } \
        { PH_BEGIN; EpiBf16<0> E{(bf16_t*)(W_ + WS_Y), D, nullptr, nullptr, 0}; GEMM_RUNM(3, WS_YCAT, ws_wout(L_), D, D, D, D, 0, E); } \
        xcd_barrier(bar, F.wave); \
        { PH_BEGIN; bf16_t* Xb = (bf16_t*)(W_ + WS_X); norm_phase<true, true>(F, true, L_, 1, 1.0f, true, L_, 2, Xb, Xb + (size_t)NCTX * D, Xb); } \
        xcd_barrier(bar, F.wave); \
        if (l == STOP_L && STOP_S == 3) goto done; \
        { PH_BEGIN; GEMM_GU(1); } \
        xcd_barrier(bar, F.wave); \
        { PH_BEGIN; EpiBf16<0> E{(bf16_t*)(W_ + WS_Y), D, nullptr, nullptr, 0}; GEMM_RUNM(3, WS_ACT, ws_wd(L_, 1), D, FF, FF, FF, 0, E); } \
        xcd_barrier(bar, F.wave); \
        { PH_BEGIN; bf16_t* Xb = (bf16_t*)(W_ + WS_X); if (l == 3 && STOP_L > 3) norm_phase<true, false>(F, true, L_, 2, 0.5f, false, 0, 0, Xb, Xb + (size_t)NCTX * D, args.out); else norm_phase<true, true>(F, true, L_, 2, 0.5f, true, L_ + 1, 0, Xb, Xb + (size_t)NCTX * D, Xb); } \
        xcd_barrier(bar, F.wave); \
        if (l == STOP_L && STOP_S == 4) goto done; \
    }
__global__ void __launch_bounds__(512, 2) mega_fwd(Args args) {
    extern __shared__ __attribute__((aligned(16))) unsigned char lds_raw[];
    Frame F;
    F.lds = (LAS unsigned char*)lds_raw;
    F.tid = 0; F.lane = 0; F.gw = 0; F.wave = __builtin_amdgcn_readfirstlane(threadIdx.x >> 6);
    F.G = gridDim.x; F.NGW = F.G * NWAVES;
    F.in = args.in; F.out = args.out; F.ws = args.ws;
    for (int u = threadIdx.x; u < (LDS_BYTES - RING_BYTES) / 4; u += 512) ((LAS unsigned*)(F.lds + RING_BYTES))[u] = 0u;
    __syncthreads();
    XcdBarrier bar = xcd_barrier_post((unsigned*)(args.ws + WS_CTL) + 4096, (volatile LAS unsigned*)(F.lds + MISC_OFF) + 8);

    phase_mod(F);
    for (int rep = 0; rep < REP_CONV; ++rep) phase_convert(F);
    xcd_barrier(bar, F.wave);
    norm_phase<false, false>(F, false, 0, 0, 0.f, true, 0, 0, args.in[I_XP], args.in[I_XS], nullptr, false);
    xcd_barrier(bar, F.wave);

    LAYER_BODY(0) LAYER_BODY(1) LAYER_BODY(2) LAYER_BODY(3)
    done:;
    if (false) { const f32x4* Xs = (const f32x4*)(args.ws + WS_X); for (size_t i = (size_t)blockIdx.x * 512 + F.wave * 64 + lane_id(); i < (size_t)MROWS * D / 4; i += (size_t)gridDim.x * 512) ((f32x4*)args.out)[i] = Xs[i]; }
}

extern "C" void kernel_launch(void* const* d_in, const int* in_sizes, int n_in, void* d_out, int out_size, void* d_ws, size_t ws_size, hipStream_t stream) {
    static int grid = 0;
    if (grid == 0) {
        if (n_in != N_IN || (size_t)out_size != OUT_TOTAL || ws_size < WS_END) { fprintf(stderr, "kernel_launch: unexpected sizes n_in %d out %d ws %zu (need %zu)\n", n_in, out_size, ws_size, (size_t)WS_END); grid = -1; return; }
        int dev = 0, cus = 0, per_cu = 0;
        if (hipGetDevice(&dev) != hipSuccess || hipDeviceGetAttribute(&cus, hipDeviceAttributeMultiprocessorCount, dev) != hipSuccess) { grid = -1; return; }
        if (hipFuncSetAttribute((const void*)mega_fwd, hipFuncAttributeMaxDynamicSharedMemorySize, LDS_BYTES) != hipSuccess) { fprintf(stderr, "kernel_launch: hipFuncSetAttribute failed\n"); grid = -1; return; }
        if (hipOccupancyMaxActiveBlocksPerMultiprocessor(&per_cu, (const void*)mega_fwd, 512, LDS_BYTES) != hipSuccess || per_cu < 1) fprintf(stderr, "kernel_launch: occupancy query says %d\n", per_cu);
        (void)hipGetLastError();
        grid = cus;
    }
    if (grid < 0) return;
    (void)hipMemsetAsync((char*)d_ws + WS_CTL, 0, CTL_ZERO_BYTES, stream);
    Args a{};
    for (int i = 0; i < N_IN; ++i) a.in[i] = (const float*)d_in[i];
    a.out = (float*)d_out; a.ws = (unsigned char*)d_ws; a.ph_lo = 0; a.ph_hi = 1 << 30;
    hipLaunchKernelGGL(mega_fwd, dim3(grid), dim3(512), LDS_BYTES, stream, a);
}
```
